# Optimizing an MI355X kernel written in HIP

```python
import jax, jax.numpy as jnp
from jax import lax
import numpy as np

D_MODEL = 1024
BATCH = 8
SEQ = 2048
DEPTH = 2
DEC_BATCH = 128
DEC_SEQ = 8
PAST_LEN = 8192
PAGE_SIZE = 128

N_MIXERS = 2
N_A_LAYERS = (DEPTH + 1) // 2
N_B_LAYERS = DEPTH // 2
CHUNK = 128
SGU_WIDTH = 2 * D_MODEL
SGU_GROUPS = 8
SGU_GROUP_DIM = SGU_WIDTH // SGU_GROUPS
HEAD_DIM = 64
N_HEADS = D_MODEL // HEAD_DIM
N_KV_HEADS = 4
GQA_GROUP = N_HEADS // N_KV_HEADS
WINDOW = 128
ROPE_THETA = 10000.0
D_FF = 2816
CONV_W = 3
EPS = 1e-6

kernel_name = 'hybrid_sgu_swa_convffn_step'


def rms_norm(x, g):
    xf = x.astype(jnp.float32)
    y = xf * lax.rsqrt(jnp.mean(xf * xf, axis=-1, keepdims=True) + EPS)
    return (y * g.astype(jnp.float32)).astype(x.dtype)


def layer_norm(x, g, b):
    xf = x.astype(jnp.float32)
    mu = jnp.mean(xf, axis=-1, keepdims=True)
    var = jnp.mean(jnp.square(xf - mu), axis=-1, keepdims=True)
    y = (xf - mu) * lax.rsqrt(var + EPS)
    return (y * g.astype(jnp.float32) + b.astype(jnp.float32)).astype(x.dtype)


def rope(x, pos):
    inv_freq = jnp.power(jnp.float32(ROPE_THETA), -jnp.arange(0, HEAD_DIM, 2, dtype=jnp.float32) / HEAD_DIM)
    ang = pos.astype(jnp.float32)[:, None] * inv_freq[None, :]
    cos = jnp.cos(ang)[None, :, None, :]
    sin = jnp.sin(ang)[None, :, None, :]
    xf = x.astype(jnp.float32)
    x1, x2 = jnp.split(xf, 2, axis=-1)
    return jnp.concatenate([x1 * cos - x2 * sin, x2 * cos + x1 * sin], axis=-1).astype(x.dtype)


def sgu_mixer(h, w_in, ln_g, ln_b, w_s, b_s, w_out):
    bsz, length, _ = h.shape
    z = jax.nn.gelu(h @ w_in)
    u, v = jnp.split(z, 2, axis=-1)
    v = layer_norm(v, ln_g, ln_b)
    n_chunks = -(-length // CHUNK)
    pad = n_chunks * CHUNK - length
    vp = jnp.pad(v, ((0, 0), (0, pad), (0, 0))).reshape(bsz, n_chunks, CHUNK, SGU_GROUPS, SGU_GROUP_DIM)
    causal = jnp.tril(jnp.ones((CHUNK, CHUNK), dtype=bool))
    w = jnp.where(causal[None], w_s, 0.0)
    mixed = jnp.einsum('gts,bnsgc->bntgc', w, vp) + b_s.T[:, :, None]
    mixed = mixed.reshape(bsz, n_chunks * CHUNK, SGU_WIDTH)[:, :length]
    return (u * mixed) @ w_out, v


def swa_project(h, w_qkv, q_norm, k_norm, pos):
    bsz, length, _ = h.shape
    qkv = h @ w_qkv
    q, k, v = jnp.split(qkv, [N_HEADS * HEAD_DIM, (N_HEADS + N_KV_HEADS) * HEAD_DIM], axis=-1)
    q = q.reshape(bsz, length, N_HEADS, HEAD_DIM)
    k = k.reshape(bsz, length, N_KV_HEADS, HEAD_DIM)
    v = v.reshape(bsz, length, N_KV_HEADS, HEAD_DIM)
    q = rope(rms_norm(q, q_norm), pos)
    k = rope(rms_norm(k, k_norm), pos)
    return q, k, v


def sink_attention(q, k, v, q_pos, k_pos, sinks):
    scale = HEAD_DIM ** -0.5
    logits = jnp.einsum('bnqkgd,bnskd->bnkgqs', q, k, preferred_element_type=jnp.float32) * scale
    rel = q_pos[:, :, None] - k_pos[:, None, :]
    valid = (rel >= 0) & (rel < WINDOW) & (k_pos[:, None, :] >= 0)
    logits = jnp.where(valid[None, :, None, None], logits, -jnp.inf)
    sink = sinks.astype(jnp.float32).reshape(1, 1, N_KV_HEADS, GQA_GROUP, 1, 1)
    m = jnp.maximum(jnp.max(logits, axis=-1, keepdims=True), sink)
    p = jnp.exp(logits - m)
    denom = jnp.sum(p, axis=-1, keepdims=True) + jnp.exp(sink - m)
    probs = (p / denom).astype(v.dtype)
    return jnp.einsum('bnkgqs,bnskd->bnqkgd', probs, v)


def swa_prompt(h, w_qkv, q_norm, k_norm, sinks, w_o):
    bsz, length, _ = h.shape
    pos = jnp.arange(length, dtype=jnp.int32)
    q, k, v = swa_project(h, w_qkv, q_norm, k_norm, pos)
    nb = length // WINDOW
    qb = q.reshape(bsz, nb, WINDOW, N_KV_HEADS, GQA_GROUP, HEAD_DIM)
    kb = k.reshape(bsz, nb, WINDOW, N_KV_HEADS, HEAD_DIM)
    vb = v.reshape(bsz, nb, WINDOW, N_KV_HEADS, HEAD_DIM)
    shift = ((0, 0), (1, 0), (0, 0), (0, 0), (0, 0))
    k_band = jnp.concatenate([jnp.pad(kb, shift)[:, :-1], kb], axis=2)
    v_band = jnp.concatenate([jnp.pad(vb, shift)[:, :-1], vb], axis=2)
    q_pos = pos.reshape(nb, WINDOW)
    k_pos = jnp.concatenate([q_pos - WINDOW, q_pos], axis=1)
    o = sink_attention(qb, k_band, v_band, q_pos, k_pos, sinks)
    y = o.reshape(bsz, length, N_HEADS * HEAD_DIM) @ w_o
    return y, k[:, -WINDOW:], v[:, -WINDOW:]


def swa_sample(h, buf_k, buf_v, w_qkv, q_norm, k_norm, sinks, w_o):
    bsz, length, _ = h.shape
    buf_len = buf_k.shape[1]
    pos = PAST_LEN + jnp.arange(length, dtype=jnp.int32)
    q, k, v = swa_project(h, w_qkv, q_norm, k_norm, pos)
    k_all = jnp.concatenate([buf_k, k], axis=1)
    v_all = jnp.concatenate([buf_v, v], axis=1)
    k_pos = jnp.concatenate([PAST_LEN - buf_len + jnp.arange(buf_len, dtype=jnp.int32), pos])
    qb = q.reshape(bsz, 1, length, N_KV_HEADS, GQA_GROUP, HEAD_DIM)
    o = sink_attention(qb, k_all[:, None], v_all[:, None], pos[None], k_pos[None], sinks)
    y = o.reshape(bsz, length, N_HEADS * HEAD_DIM) @ w_o
    return y, k_all[:, -WINDOW:], v_all[:, -WINDOW:]


def conv_ffn(h, past, norm_g, w_up, conv_w, conv_b, w_down):
    length = h.shape[1]
    a = rms_norm(h, norm_g) @ w_up
    a_ext = jnp.concatenate([past.astype(a.dtype), a], axis=1)
    c = conv_b + sum(conv_w[j] * a_ext[:, j:j + length] for j in range(CONV_W))
    gate, val = jnp.split(c, 2, axis=-1)
    y = (jax.nn.silu(gate) * val) @ w_down
    return y, a_ext[:, -(CONV_W - 1):]


def setup_inputs(seed: int = 0) -> dict:
    key = jax.random.key(seed)
    ks = jax.random.split(key, 32)
    f32 = jnp.float32
    nrm = lambda k, shape, scale: jax.random.normal(k, shape, f32) * scale
    qkv_out = (N_HEADS + 2 * N_KV_HEADS) * HEAD_DIM
    buf_len = min(WINDOW, PAST_LEN)
    return {
        'x_prompt': nrm(ks[0], (BATCH, SEQ, D_MODEL), 1.0),
        'x_sample': nrm(ks[1], (DEC_BATCH, DEC_SEQ, D_MODEL), 1.0),
        'cache_swa_k': nrm(ks[2], (N_B_LAYERS, DEC_BATCH, buf_len, N_KV_HEADS, HEAD_DIM), 1.0),
        'cache_swa_v': nrm(ks[3], (N_B_LAYERS, DEC_BATCH, buf_len, N_KV_HEADS, HEAD_DIM), 1.0),
        'state_ffn_conv': nrm(ks[4], (DEPTH, DEC_BATCH, CONV_W - 1, 2 * D_FF), 1.0),
        'mix_norm_g': 1.0 + nrm(ks[5], (DEPTH, D_MODEL), 0.02),
        'sgu_w_in': nrm(ks[6], (N_A_LAYERS, D_MODEL, 2 * SGU_WIDTH), D_MODEL ** -0.5),
        'sgu_ln_g': 1.0 + nrm(ks[7], (N_A_LAYERS, SGU_WIDTH), 0.02),
        'sgu_ln_b': nrm(ks[8], (N_A_LAYERS, SGU_WIDTH), 0.02),
        'sgu_w_s': nrm(ks[9], (N_A_LAYERS, SGU_GROUPS, CHUNK, CHUNK), CHUNK ** -0.5),
        'sgu_b_s': 1.0 + nrm(ks[10], (N_A_LAYERS, SGU_GROUPS, CHUNK), 0.1),
        'sgu_w_out': nrm(ks[11], (N_A_LAYERS, SGU_WIDTH, D_MODEL), SGU_WIDTH ** -0.5),
        'attn_w_qkv': nrm(ks[12], (N_B_LAYERS, D_MODEL, qkv_out), D_MODEL ** -0.5),
        'attn_q_norm': 1.0 + nrm(ks[13], (N_B_LAYERS, HEAD_DIM), 0.02),
        'attn_k_norm': 1.0 + nrm(ks[14], (N_B_LAYERS, HEAD_DIM), 0.02),
        'attn_sinks': nrm(ks[15], (N_B_LAYERS, N_HEADS), 1.0),
        'attn_w_o': nrm(ks[16], (N_B_LAYERS, N_HEADS * HEAD_DIM, D_MODEL), (N_HEADS * HEAD_DIM) ** -0.5),
        'ffn_norm_g': 1.0 + nrm(ks[17], (DEPTH, D_MODEL), 0.02),
        'ffn_w_up': nrm(ks[18], (DEPTH, D_MODEL, 2 * D_FF), D_MODEL ** -0.5),
        'ffn_conv_w': nrm(ks[19], (DEPTH, CONV_W, 2 * D_FF), CONV_W ** -0.5),
        'ffn_conv_b': nrm(ks[20], (DEPTH, 2 * D_FF), 0.02),
        'ffn_w_down': nrm(ks[21], (DEPTH, D_FF, D_MODEL), D_FF ** -0.5),
    }


def reference(x_prompt, x_sample, cache_swa_k, cache_swa_v, state_ffn_conv,
              mix_norm_g, sgu_w_in, sgu_ln_g, sgu_ln_b, sgu_w_s, sgu_b_s, sgu_w_out,
              attn_w_qkv, attn_q_norm, attn_k_norm, attn_sinks, attn_w_o,
              ffn_norm_g, ffn_w_up, ffn_conv_w, ffn_conv_b, ffn_w_down):
    yp, ys = x_prompt, x_sample
    sgu_v_s = []
    kp, vp, ksm, vsm = [], [], [], []
    conv_p, conv_s = [], []
    for layer in range(DEPTH):
        j = layer // N_MIXERS
        hp = rms_norm(yp, mix_norm_g[layer])
        hs = rms_norm(ys, mix_norm_g[layer])
        if layer % N_MIXERS == 0:
            sgu_args = (sgu_w_in[j], sgu_ln_g[j], sgu_ln_b[j], sgu_w_s[j], sgu_b_s[j], sgu_w_out[j])
            op, _ = sgu_mixer(hp, *sgu_args)
            os_, v_rows = sgu_mixer(hs, *sgu_args)
            sgu_v_s.append(v_rows)
        else:
            op, k_p, v_p = swa_prompt(hp, attn_w_qkv[j], attn_q_norm[j], attn_k_norm[j], attn_sinks[j], attn_w_o[j])
            os_, k_s, v_s = swa_sample(hs, cache_swa_k[j], cache_swa_v[j], attn_w_qkv[j], attn_q_norm[j],
                                       attn_k_norm[j], attn_sinks[j], attn_w_o[j])
            kp.append(k_p); vp.append(v_p); ksm.append(k_s); vsm.append(v_s)
        yp = yp + op
        ys = ys + os_
        zero_past = jnp.zeros((yp.shape[0], CONV_W - 1, 2 * D_FF), dtype=yp.dtype)
        fp, cp = conv_ffn(yp, zero_past, ffn_norm_g[layer], ffn_w_up[layer], ffn_conv_w[layer], ffn_conv_b[layer], ffn_w_down[layer])
        fs, cs = conv_ffn(ys, state_ffn_conv[layer], ffn_norm_g[layer], ffn_w_up[layer], ffn_conv_w[layer], ffn_conv_b[layer], ffn_w_down[layer])
        yp = yp + fp
        ys = ys + fs
        conv_p.append(cp); conv_s.append(cs)
    return (yp, ys, jnp.stack(sgu_v_s), jnp.stack(kp), jnp.stack(vp), jnp.stack(ksm), jnp.stack(vsm),
            jnp.stack(conv_p), jnp.stack(conv_s))
```

```cpp
#include <hip/hip_runtime.h>
#include <cstdio>
#include <cstdint>

#define REP_P0 1
#define REP_P2 1
#define REP_P8 1
#define REP_P9 1
#define REP_P4 1
#define REP_P4NULL 0
#define REP_P1 1
#define REP_P3 1
#define REP_P7 1
#define PROBE_P3NULL 0
constexpr int DM = 1024, NP = 16384, NS = 1024, T = NP + NS;
constexpr int SEQ = 2048, NBP = 8, NBS = 128, DSEQ = 8, PAST = 8192;
constexpr int SW = 2048, DFF = 2816, UPW = 5632, QKVW = 1536, NH = 16, NKV = 4, HD = 64;
constexpr float EPS = 1e-6f;
constexpr float QSCALE = 0.125f * 1.4426950408889634f;
constexpr float LOG2E = 1.4426950408889634f;

constexpr size_t O_Y = 0, O_SGUV = 17825792, O_CKP = 19922944, O_CVP = 20185088, O_CKS = 20447232, O_CVS = 24641536, O_STP = 28835840, O_STS = 29016064;

constexpr size_t MiB = 1u << 20;
constexpr size_t WS_CTL = 0, CTL_ZERO_BYTES = 1 * MiB;
constexpr size_t WS_HB = 1 * MiB;
constexpr size_t WS_WSB = 7 * MiB;
constexpr size_t WS_ROPE = 7 * MiB + 256 * 1024;
constexpr size_t WS_WIN = 8 * MiB, WS_WOUT = 16 * MiB, WS_WUP0 = 20 * MiB, WS_WUP1 = 31 * MiB, WS_WDN0 = 42 * MiB, WS_WDN1 = 47 * MiB + 512 * 1024;
constexpr size_t WS_WQKV = 53 * MiB, WS_WO = 56 * MiB;
constexpr size_t WS_XB = 58 * MiB;
constexpr size_t WS_BIG = 92 * MiB;
constexpr size_t WS_U = WS_BIG, WS_V = WS_BIG + 68 * MiB;
constexpr size_t WS_G = WS_BIG;
constexpr size_t WS_QKV = WS_BIG, WS_QO = WS_BIG + 51 * MiB, WS_KN = WS_BIG + 85 * MiB, WS_VT = WS_BIG + 94 * MiB;
constexpr size_t WS_END = 256 * MiB;
constexpr int CW_BAR = 4096;
constexpr size_t CTL_LNS = 256 * 1024;
constexpr size_t CTL_RSS = 512 * 1024;

constexpr int RING_BYTES = 131072, XS_OFF = RING_BYTES, XS_BYTES = 8192, XP_OFF = XS_OFF + XS_BYTES, XP_BYTES = 5120, LDSCTL_OFF = XP_OFF + XP_BYTES, MISC_OFF = LDSCTL_OFF + 320, LDS_BYTES = 147456;
static_assert(MISC_OFF + 128 <= LDS_BYTES, "LDS map");

#define GAS __attribute__((address_space(1)))
#define LAS __attribute__((address_space(3)))
typedef unsigned short bf16;
typedef unsigned v4u __attribute__((ext_vector_type(4)));
typedef unsigned v2u __attribute__((ext_vector_type(2)));
typedef float f32x4 __attribute__((ext_vector_type(4)));
typedef float f32x2 __attribute__((ext_vector_type(2)));
typedef float f32x16 __attribute__((ext_vector_type(16)));
typedef short bf16x8 __attribute__((ext_vector_type(8)));
typedef GAS unsigned gu32;

typedef __bf16 bf16x2_hw __attribute__((ext_vector_type(2)));
__device__ __forceinline__ unsigned pk2(float lo, float hi) { const f32x2 v = {lo, hi}; return __builtin_bit_cast(unsigned, __builtin_convertvector(v, bf16x2_hw)); }
__device__ __forceinline__ unsigned f2bf(float f) { return pk2(f, 0.f) & 0xffffu; }
__device__ __forceinline__ float bflo(unsigned w) { return __uint_as_float(w << 16); }
__device__ __forceinline__ float bfhi(unsigned w) { return __uint_as_float(w & 0xffff0000u); }
__device__ __forceinline__ float bf1(bf16 x) { return __uint_as_float((unsigned)x << 16); }
__device__ __forceinline__ unsigned cvt_pk_bf16(float lo, float hi) { unsigned r; asm volatile("v_cvt_pk_bf16_f32 %0, %1, %2" : "=v"(r) : "v"(lo), "v"(hi)); return r; }
__device__ __forceinline__ float gelu_tanh(float x) {
    const float u = x * (0.7978845608f + 0.0356774081f * x * x);
    const float e = __builtin_amdgcn_exp2f(-2.885390082f * u);
    return x * __builtin_amdgcn_rcpf(1.0f + e);
}
__device__ __forceinline__ f32x2 gelu_tanh2(f32x2 x) {
    const f32x2 x2 = x * x; const f32x2 a = x * (x2 * (-0.10294323948f) + (-2.3022081983f));
    f32x2 e; e.x = __builtin_amdgcn_exp2f(a.x); e.y = __builtin_amdgcn_exp2f(a.y);
    const f32x2 d = e + 1.0f; f32x2 r; r.x = __builtin_amdgcn_rcpf(d.x); r.y = __builtin_amdgcn_rcpf(d.y);
    return x * r;
}
__device__ __forceinline__ f32x2 silu_mul2(f32x2 g, f32x2 v) {
    const f32x2 a = g * (-LOG2E); f32x2 e; e.x = __builtin_amdgcn_exp2f(a.x); e.y = __builtin_amdgcn_exp2f(a.y);
    const f32x2 d = e + 1.0f; f32x2 r; r.x = __builtin_amdgcn_rcpf(d.x); r.y = __builtin_amdgcn_rcpf(d.y);
    return (g * r) * v;
}
__device__ __forceinline__ float silu_f(float x) { return x * __builtin_amdgcn_rcpf(1.0f + __builtin_amdgcn_exp2f(-LOG2E * x)); }
__device__ __forceinline__ float dpp_shr1(float oldv, float src) {
    return __builtin_bit_cast(float, __builtin_amdgcn_update_dpp(__builtin_bit_cast(int, oldv), __builtin_bit_cast(int, src), 0x111, 0xf, 0xf, false));
}

__device__ __forceinline__ int tid_fresh() { int t = threadIdx.x; asm volatile("" : "+v"(t)); return t; }
namespace pg8 {
#define PG8_LAS __attribute__((address_space(3)))
typedef unsigned short bf16_t;
typedef unsigned u32x4 __attribute__((ext_vector_type(4)));
constexpr int BM = 256, BK = 64, HALF = 128, HTB = HALF * BK * 2, STAGE_BYTES = 8 * HTB, NXCD = 8, WGM = 8;

__host__ __device__ __forceinline__ int lds_byte(int r, int c) { const int st = (r >> 4) * 2 + (c >> 5), rr = r & 15, cc = c & 31, ob = rr * 64 + cc * 2; return st * 1024 + (ob ^ (((ob >> 9) & 1) << 5)); }
__host__ __device__ __forceinline__ void stage_rc(int b, int& R, int& C) { const int st = b / 1024, sb = b % 1024, swz = sb ^ (((sb >> 9) & 1) << 5); R = (st >> 1) * 16 + swz / 64; C = (st & 1) * 32 + (swz % 64) / 2; }
__host__ __device__ __forceinline__ int perm32(int rho) { const int n = rho >> 4, i = rho & 15; return 8 * (i >> 2) + 4 * n + (i & 3); }

struct Unit { int pm, pn; };
struct Gemm { const bf16_t* A; const bf16_t* Bt; int M, N, K; };

struct StaticOrder {
    int nM, nN, nwg, G, c;
    __host__ __device__ __forceinline__ void init(int M, int N, int G_, int c_) { nM = M / BM; nN = N / BM; nwg = nM * nN; G = G_; c = c_; }
    __host__ __device__ __forceinline__ bool next(int i, Unit& u) const {
        const long L = (long)i * G + c; if (L >= nwg) return false;
        int wgid = (int)L; { const int q = nwg / NXCD, r = nwg % NXCD, xcd = wgid % NXCD, off = wgid / NXCD; wgid = (xcd < r ? xcd * (q + 1) : r * (q + 1) + (xcd - r) * q) + off; }
        const int nig = WGM * nN, gid = wgid / nig, fm = gid * WGM, gsz = (nM - fm) < WGM ? (nM - fm) : WGM;
        u.pm = fm + ((wgid % nig) % gsz); u.pn = (wgid % nig) / gsz; return true;
    }
    __device__ __forceinline__ void a_ready(const Unit&) const {}
    __device__ __forceinline__ void done(const Unit&) const {}
};


struct EpiGelu {
    static constexpr bool FUSEX = false;
    static constexpr bool WCOL = true, PDMA = false, PERM = true, PERMA = false, RIDE = true;
    bf16_t* U; bf16_t* V; float* lnS;
    __device__ __forceinline__ void operator()(f32x4 (&acc)[2][2][4][2], const Unit& u, int wr, int wc, int fr, int fq) const {
        const bool isv = u.pn >= 8; bf16_t* base = isv ? V : U;
        const int colt = (u.pn & 7) * BM + wc * 64 + 8 * fq, row0 = u.pm * BM + wr * 64 + fr;
#pragma unroll
        for (int ai = 0; ai < 2; ++ai)
#pragma unroll
            for (int m = 0; m < 4; ++m) { const int row = row0 + ai * HALF + m * 16; bf16_t* rowp = base + (size_t)row * SW + colt; float s = 0.f, q = 0.f;
#pragma unroll
                for (int bj = 0; bj < 2; ++bj) { f32x4 v0 = acc[ai][bj][m][0], v1 = acc[ai][bj][m][1];
                    { const f32x2 a = gelu_tanh2((f32x2){v0[0], v0[1]}), b = gelu_tanh2((f32x2){v0[2], v0[3]}), c = gelu_tanh2((f32x2){v1[0], v1[1]}), d = gelu_tanh2((f32x2){v1[2], v1[3]});
                      v0 = (f32x4){a.x, a.y, b.x, b.y}; v1 = (f32x4){c.x, c.y, d.x, d.y}; }
                    if (isv) {
#pragma unroll
                        for (int x = 0; x < 4; ++x) { s += v0[x] + v1[x]; q += v0[x] * v0[x] + v1[x] * v1[x]; } }
                    u32x4 w; w.x = cvt_pk_bf16(v0[0], v0[1]); w.y = cvt_pk_bf16(v0[2], v0[3]); w.z = cvt_pk_bf16(v1[0], v1[1]); w.w = cvt_pk_bf16(v1[2], v1[3]);
                    *(u32x4*)(rowp + (bj ^ wr) * 32) = w; }
                if (isv) { s += __shfl_xor(s, 16); s += __shfl_xor(s, 32); q += __shfl_xor(q, 16); q += __shfl_xor(q, 32);
                    if (fq == 0) { atomicAdd(lnS + 2 * row, s); atomicAdd(lnS + 2 * row + 1, q); } } }
    }
    __device__ __forceinline__ void extra(const f32x4 (&ax)[2], const Unit& u, int wr, int wc, int fr, int fq) const {
        const bool isv = u.pn >= 8; bf16_t* base = isv ? V : U; const int row = NP + 16 * u.pm + fr;
        f32x4 v0 = ax[0], v1 = ax[1];
        { const f32x2 a = gelu_tanh2((f32x2){v0[0], v0[1]}), b = gelu_tanh2((f32x2){v0[2], v0[3]}), c = gelu_tanh2((f32x2){v1[0], v1[1]}), d = gelu_tanh2((f32x2){v1[2], v1[3]});
          v0 = (f32x4){a.x, a.y, b.x, b.y}; v1 = (f32x4){c.x, c.y, d.x, d.y}; }
        u32x4 w; w.x = cvt_pk_bf16(v0[0], v0[1]); w.y = cvt_pk_bf16(v0[2], v0[3]); w.z = cvt_pk_bf16(v1[0], v1[1]); w.w = cvt_pk_bf16(v1[2], v1[3]);
        *(u32x4*)(base + (size_t)row * SW + (u.pn & 7) * BM + wc * 64 + wr * 32 + 8 * fq) = w;
        if (isv) { float s = 0.f, q = 0.f;
#pragma unroll
            for (int x = 0; x < 4; ++x) { s += v0[x] + v1[x]; q += v0[x] * v0[x] + v1[x] * v1[x]; }
            s += __shfl_xor(s, 16); s += __shfl_xor(s, 32); q += __shfl_xor(q, 16); q += __shfl_xor(q, 32);
            if (fq == 0) { atomicAdd(lnS + 2 * row, s); atomicAdd(lnS + 2 * row + 1, q); } }
    }
};

template <int MODE> struct EpiResid {
    static constexpr bool WCOL = true, PDMA = false, PERM = true, PERMA = false, RIDE = true;
    const float* base_p; const float* base_s; float* out; bf16_t* XB; float* rss;
    __device__ __forceinline__ void row8(const f32x4& a0, const f32x4& a1, size_t off, bool samp, float& ss) const {
        f32x4 b0, b1;
        if (MODE == 0) { const float* bb = samp ? (base_s - (size_t)NP * DM) : base_p; b0 = *(const f32x4*)(bb + off); b1 = *(const f32x4*)(bb + off + 4); }
        else { const u32x4 r = *(const u32x4*)(XB + off); b0 = (f32x4){bflo(r.x), bfhi(r.x), bflo(r.y), bfhi(r.y)}; b1 = (f32x4){bflo(r.z), bfhi(r.z), bflo(r.w), bfhi(r.w)}; }
        const f32x4 o0 = b0 + a0, o1 = b1 + a1;
        if (MODE == 2) { *(f32x4*)(out + off) = o0; *(f32x4*)(out + off + 4) = o1; }
        else {
#pragma unroll
            for (int x = 0; x < 4; ++x) ss += o0[x] * o0[x] + o1[x] * o1[x];
            u32x4 w; w.x = cvt_pk_bf16(o0[0], o0[1]); w.y = cvt_pk_bf16(o0[2], o0[3]); w.z = cvt_pk_bf16(o1[0], o1[1]); w.w = cvt_pk_bf16(o1[2], o1[3]);
            *(u32x4*)(XB + off) = w; }
    }
    __device__ __forceinline__ void fin8(const f32x4& b0, const f32x4& b1, const f32x4& a0, const f32x4& a1, size_t off, float& ss) const {
        const f32x4 o0 = b0 + a0, o1 = b1 + a1;
        if (MODE == 2) { *(f32x4*)(out + off) = o0; *(f32x4*)(out + off + 4) = o1; }
        else {
#pragma unroll
            for (int x = 0; x < 4; ++x) ss += o0[x] * o0[x] + o1[x] * o1[x];
            u32x4 w; w.x = cvt_pk_bf16(o0[0], o0[1]); w.y = cvt_pk_bf16(o0[2], o0[3]); w.z = cvt_pk_bf16(o1[0], o1[1]); w.w = cvt_pk_bf16(o1[2], o1[3]);
            *(u32x4*)(XB + off) = w; }
    }
    static constexpr bool FUSEX = true;
    __device__ __forceinline__ void fused(f32x4 (&acc)[2][2][4][2], const f32x4 (&ax)[2], const Unit& u, int wr, int wc, int fr, int fq) const {
        const int row0 = u.pm * BM + wr * 64 + fr, col0 = u.pn * BM + wc * 64 + 8 * fq; const bool samp = u.pm >= NP / BM;
        const int rowx = NP + 16 * u.pm + fr; const size_t offx = (size_t)rowx * DM + u.pn * BM + wc * 64 + wr * 32 + 8 * fq;
        f32x4 xb0, xb1; u32x4 xraw;
        if (MODE == 0) { const float* bx_ = base_s - (size_t)NP * DM; xb0 = *(const f32x4*)(bx_ + offx); xb1 = *(const f32x4*)(bx_ + offx + 4); }
        else xraw = *(const u32x4*)(XB + offx);
#define RES_X() do { float ssx = 0.f; if (MODE != 0) { xb0 = (f32x4){bflo(xraw.x), bfhi(xraw.x), bflo(xraw.y), bfhi(xraw.y)}; xb1 = (f32x4){bflo(xraw.z), bfhi(xraw.z), bflo(xraw.w), bfhi(xraw.w)}; } \
            fin8(xb0, xb1, ax[0], ax[1], offx, ssx); if (MODE != 2) { ssx += __shfl_xor(ssx, 16); ssx += __shfl_xor(ssx, 32); if (fq == 0) atomicAdd(rss + rowx, ssx); } } while (0)
        if (MODE == 0) {
            const float* bb = samp ? (base_s - (size_t)NP * DM) : base_p;
            f32x4 rb[2][2][2][2];
#define RES_LD0(q_) do { _Pragma("unroll") for (int mm = 0; mm < 2; ++mm) _Pragma("unroll") for (int bj = 0; bj < 2; ++bj) { \
                const size_t off_ = (size_t)(row0 + ((q_) >> 1) * HALF + (((q_) & 1) * 2 + mm) * 16) * DM + col0 + (bj ^ wr) * 32; rb[(q_) & 1][mm][bj][0] = *(const f32x4*)(bb + off_); rb[(q_) & 1][mm][bj][1] = *(const f32x4*)(bb + off_ + 4); } } while (0)
            RES_LD0(0);
            RES_X();
#pragma unroll
            for (int q = 0; q < 4; ++q) { if (q + 1 < 4) RES_LD0(q + 1);
#pragma unroll
                for (int mm = 0; mm < 2; ++mm) { const int ai = q >> 1, m = (q & 1) * 2 + mm, row = row0 + ai * HALF + m * 16; const size_t off = (size_t)row * DM + col0; float ss = 0.f;
#pragma unroll
                    for (int bj = 0; bj < 2; ++bj) fin8(rb[q & 1][mm][bj][0], rb[q & 1][mm][bj][1], acc[ai][bj][m][0], acc[ai][bj][m][1], off + (bj ^ wr) * 32, ss);
                    ss += __shfl_xor(ss, 16); ss += __shfl_xor(ss, 32); if (fq == 0) atomicAdd(rss + row, ss); } }
#undef RES_LD0
        } else {
            u32x4 rb[2][4][2];
#define RES_LD1(ai_, m_) do { _Pragma("unroll") for (int bj = 0; bj < 2; ++bj) rb[ai_][m_][bj] = *(const u32x4*)(XB + (size_t)(row0 + (ai_) * HALF + (m_) * 16) * DM + col0 + (bj ^ wr) * 32); } while (0)
#pragma unroll
            for (int q = 0; q < 6; ++q) RES_LD1(q >> 2, q & 3);
            RES_X();
#pragma unroll
            for (int ai = 0; ai < 2; ++ai)
#pragma unroll
                for (int m = 0; m < 4; ++m) { const int row = row0 + ai * HALF + m * 16; const size_t off = (size_t)row * DM + col0; float ss = 0.f;
                    if (ai == 0 && m == 1) RES_LD1(1, 2);
                    if (ai == 0 && m == 2) RES_LD1(1, 3);
#pragma unroll
                    for (int bj = 0; bj < 2; ++bj) { const u32x4 r = rb[ai][m][bj];
                        fin8((f32x4){bflo(r.x), bfhi(r.x), bflo(r.y), bfhi(r.y)}, (f32x4){bflo(r.z), bfhi(r.z), bflo(r.w), bfhi(r.w)}, acc[ai][bj][m][0], acc[ai][bj][m][1], off + (bj ^ wr) * 32, ss); }
                if (MODE != 2) { ss += __shfl_xor(ss, 16); ss += __shfl_xor(ss, 32); if (fq == 0) atomicAdd(rss + row, ss); } }
        }
#undef RES_X
#undef RES_LD1
    }
    __device__ __forceinline__ void extra(const f32x4 (&ax)[2], const Unit& u, int wr, int wc, int fr, int fq) const {
        const int row = NP + 16 * u.pm + fr; const size_t off = (size_t)row * DM + u.pn * BM + wc * 64 + wr * 32 + 8 * fq; float ss = 0.f;
        row8(ax[0], ax[1], off, true, ss);
        if (MODE != 2) { ss += __shfl_xor(ss, 16); ss += __shfl_xor(ss, 32); if (fq == 0) atomicAdd(rss + row, ss); }
    }
};

struct EpiQKV {
    static constexpr bool WCOL = false, PDMA = false, PERM = true, PERMA = true, RIDE = false;
    bf16_t* QO; bf16_t* Kn; bf16_t* Vt; bf16_t* Vs; const float* rss; const float* qn; const float* kn; const f32x2* rope; float* out;
    __device__ __forceinline__ void operator()(f32x4 (&acc)[2][2][4][2], const Unit& u, int wr, int wc, int fr, int fq) const {
        const bool samp = u.pm >= NP / BM;
        if (u.pn < 5) {
            const bool isk = u.pn == 4; const float* gn = isk ? kn : qn; const float osc = isk ? 1.0f : QSCALE;
            const f32x4 gl0 = *(const f32x4*)(gn + 8 * fq), gl1 = *(const f32x4*)(gn + 8 * fq + 4), gh0 = *(const f32x4*)(gn + 32 + 8 * fq), gh1 = *(const f32x4*)(gn + 32 + 8 * fq + 4);
            const f32x4* sp = (const f32x4*)(rope + 32 + 8 * fq); const f32x4 st0 = sp[0], st1 = sp[1], st2 = sp[2], st3 = sp[3];
            f32x4 tb[2][4], r4s[2];
#define QKV_TLOAD(ai_) do { const int row0_ = u.pm * BM + (ai_) * HALF + wr * 64 + 4 * fr; r4s[ai_] = *(const f32x4*)(rss + row0_); \
                const int pi0_ = samp ? SEQ + (row0_ & 7) : (row0_ & (SEQ - 1)); const f32x4* tp_ = (const f32x4*)(rope + pi0_ * 32 + 8 * fq); \
                tb[ai_][0] = tp_[0]; tb[ai_][1] = tp_[1]; tb[ai_][2] = tp_[2]; tb[ai_][3] = tp_[3]; } while (0)
            QKV_TLOAD(0);
#pragma unroll
            for (int ai = 0; ai < 2; ++ai) { const int row0 = u.pm * BM + ai * HALF + wr * 64 + 4 * fr; const f32x4 r4 = r4s[ai];
                f32x4 t0 = tb[ai][0], t1 = tb[ai][1], t2 = tb[ai][2], t3 = tb[ai][3];
#pragma unroll
                for (int m = 0; m < 4; ++m) { const int row = row0 + m; const float rs = __builtin_amdgcn_rsqf(r4[m] * (1.0f / DM) + EPS);
                    if (ai == 0 && m == 1) QKV_TLOAD(1);
                    if (m > 0) {
#define ROT_STEP(t_, s_) do { const f32x4 o_ = t_; t_[0] = o_[0] * s_[0] - o_[1] * s_[1]; t_[1] = o_[1] * s_[0] + o_[0] * s_[1]; t_[2] = o_[2] * s_[2] - o_[3] * s_[3]; t_[3] = o_[3] * s_[2] + o_[2] * s_[3]; } while (0)
                        ROT_STEP(t0, st0); ROT_STEP(t1, st1); ROT_STEP(t2, st2); ROT_STEP(t3, st3);
#undef ROT_STEP
                    }
                    f32x4 l0 = acc[ai][0][m][0] * rs, l1 = acc[ai][0][m][1] * rs, h0 = acc[ai][1][m][0] * rs, h1 = acc[ai][1][m][1] * rs;
                    float ss = 0.f;
#pragma unroll
                    for (int x = 0; x < 4; ++x) ss += l0[x] * l0[x] + l1[x] * l1[x] + h0[x] * h0[x] + h1[x] * h1[x];
                    ss += __shfl_xor(ss, 16); ss += __shfl_xor(ss, 32);
                    const float hr = __builtin_amdgcn_rsqf(ss * (1.0f / HD) + EPS);
                    l0 = l0 * hr * gl0; l1 = l1 * hr * gl1; h0 = h0 * hr * gh0; h1 = h1 * hr * gh1;
                    f32x4 ol0, ol1, oh0, oh1;
                    ol0[0] = l0[0] * t0[0] - h0[0] * t0[1]; oh0[0] = h0[0] * t0[0] + l0[0] * t0[1]; ol0[1] = l0[1] * t0[2] - h0[1] * t0[3]; oh0[1] = h0[1] * t0[2] + l0[1] * t0[3];
                    ol0[2] = l0[2] * t1[0] - h0[2] * t1[1]; oh0[2] = h0[2] * t1[0] + l0[2] * t1[1]; ol0[3] = l0[3] * t1[2] - h0[3] * t1[3]; oh0[3] = h0[3] * t1[2] + l0[3] * t1[3];
                    ol1[0] = l1[0] * t2[0] - h1[0] * t2[1]; oh1[0] = h1[0] * t2[0] + l1[0] * t2[1]; ol1[1] = l1[1] * t2[2] - h1[1] * t2[3]; oh1[1] = h1[1] * t2[2] + l1[1] * t2[3];
                    ol1[2] = l1[2] * t3[0] - h1[2] * t3[1]; oh1[2] = h1[2] * t3[0] + l1[2] * t3[1]; ol1[3] = l1[3] * t3[2] - h1[3] * t3[3]; oh1[3] = h1[3] * t3[2] + l1[3] * t3[3];
                    u32x4 wl, wh;
                    wl.x = cvt_pk_bf16(ol0[0] * osc, ol0[1] * osc); wl.y = cvt_pk_bf16(ol0[2] * osc, ol0[3] * osc); wl.z = cvt_pk_bf16(ol1[0] * osc, ol1[1] * osc); wl.w = cvt_pk_bf16(ol1[2] * osc, ol1[3] * osc);
                    wh.x = cvt_pk_bf16(oh0[0] * osc, oh0[1] * osc); wh.y = cvt_pk_bf16(oh0[2] * osc, oh0[3] * osc); wh.z = cvt_pk_bf16(oh1[0] * osc, oh1[1] * osc); wh.w = cvt_pk_bf16(oh1[2] * osc, oh1[3] * osc);
                    { bf16_t* d = isk ? Kn + (size_t)row * 256 + wc * HD + 8 * fq : QO + (size_t)row * DM + (4 * u.pn + wc) * HD + 8 * fq; *(u32x4*)d = wl; *(u32x4*)(d + 32) = wh; }
                    if (isk) {
                        float* co = nullptr;
                        if (samp) co = out + O_CKS + (((size_t)((row - NP) >> 3) * 128 + 120 + (row & 7)) * NKV + wc) * HD + 8 * fq;
                        else if ((row & (SEQ - 1)) >= SEQ - 128) co = out + O_CKP + (((size_t)(row >> 11) * 128 + ((row & (SEQ - 1)) - (SEQ - 128))) * NKV + wc) * HD + 8 * fq;
                        if (co) { *(f32x4*)co = ol0; *(f32x4*)(co + 4) = ol1; *(f32x4*)(co + 32) = oh0; *(f32x4*)(co + 36) = oh1; } }
                } }
        } else {
            f32x4 r4v[2];
#pragma unroll
            for (int ai = 0; ai < 2; ++ai) r4v[ai] = *(const f32x4*)(rss + u.pm * BM + ai * HALF + wr * 64 + 4 * fr);
#pragma unroll
            for (int ai = 0; ai < 2; ++ai) { const int row0 = u.pm * BM + ai * HALF + wr * 64 + 4 * fr; const f32x4 r4 = r4v[ai];
                f32x4 rs4;
#pragma unroll
                for (int m = 0; m < 4; ++m) rs4[m] = __builtin_amdgcn_rsqf(r4[m] * (1.0f / DM) + EPS);
#pragma unroll
                for (int bj = 0; bj < 2; ++bj) { const int kvh = 2 * bj + (wc >> 1), d0 = 32 * (wc & 1) + 8 * fq;
                    if (!samp) { bf16_t* vp = Vt + ((size_t)((u.pm >> 3) * NKV + kvh) * HD + d0) * SEQ + (row0 & (SEQ - 1));
#pragma unroll
                        for (int n = 0; n < 2; ++n)
#pragma unroll
                            for (int x = 0; x < 4; ++x) { v2u w; w.x = cvt_pk_bf16(acc[ai][bj][0][n][x] * rs4[0], acc[ai][bj][1][n][x] * rs4[1]); w.y = cvt_pk_bf16(acc[ai][bj][2][n][x] * rs4[2], acc[ai][bj][3][n][x] * rs4[3]);
                                *(v2u*)(vp + (size_t)(4 * n + x) * SEQ) = w; }
                        if ((u.pm & 7) == 7 && ai == 1) {
#pragma unroll
                            for (int m = 0; m < 4; ++m) { float* co = out + O_CVP + (((size_t)(u.pm >> 3) * 128 + ((row0 + m) & 127)) * NKV + kvh) * HD + d0;
                                *(f32x4*)co = acc[ai][bj][m][0] * rs4[m]; *(f32x4*)(co + 4) = acc[ai][bj][m][1] * rs4[m]; } }
                    } else {
#pragma unroll
                        for (int m = 0; m < 4; ++m) { const int row = row0 + m; const f32x4 v0 = acc[ai][bj][m][0] * rs4[m], v1 = acc[ai][bj][m][1] * rs4[m];
                            u32x4 w; w.x = cvt_pk_bf16(v0[0], v0[1]); w.y = cvt_pk_bf16(v0[2], v0[3]); w.z = cvt_pk_bf16(v1[0], v1[1]); w.w = cvt_pk_bf16(v1[2], v1[3]);
                            *(u32x4*)(Vs + (size_t)(row - NP) * 256 + kvh * HD + d0) = w;
                            float* co = out + O_CVS + (((size_t)((row - NP) >> 3) * 128 + 120 + (row & 7)) * NKV + kvh) * HD + d0; *(f32x4*)co = v0; *(f32x4*)(co + 4) = v1; } } } }
        }
    }
};

struct EpiNull {
    static constexpr bool WCOL = false, PDMA = false, PERM = true, PERMA = true, RIDE = false;
    float* D;
    __device__ __forceinline__ void operator()(f32x4 (&acc)[2][2][4][2], const Unit& u, int wr, int wc, int fr, int fq) const {
        f32x4 s = (f32x4){0.f, 0.f, 0.f, 0.f};
#pragma unroll
        for (int ai = 0; ai < 2; ++ai)
#pragma unroll
            for (int bj = 0; bj < 2; ++bj)
#pragma unroll
                for (int m = 0; m < 4; ++m) { s += acc[ai][bj][m][0]; s += acc[ai][bj][m][1]; }
        D[((size_t)(u.pm * 32 + u.pn) * 8 + wr * 4 + wc) * 64 + fq * 16 + fr] = s[0] + s[1] + s[2] + s[3];
    }
};

template <bool RIDE_> struct EpiNull2 {
    static constexpr bool WCOL = false, PDMA = false, PERM = true, PERMA = false, RIDE = RIDE_;
    float* D;
    __device__ __forceinline__ void operator()(f32x4 (&acc)[2][2][4][2], const Unit& u, int wr, int wc, int fr, int fq) const {
        f32x4 s = (f32x4){0.f, 0.f, 0.f, 0.f};
#pragma unroll
        for (int ai = 0; ai < 2; ++ai)
#pragma unroll
            for (int bj = 0; bj < 2; ++bj)
#pragma unroll
                for (int m = 0; m < 4; ++m) { s += acc[ai][bj][m][0]; s += acc[ai][bj][m][1]; }
        D[((size_t)(u.pm * 32 + u.pn) * 8 + wr * 4 + wc) * 64 + fq * 16 + fr] = s[0] + s[1] + s[2] + s[3];
    }
    __device__ __forceinline__ void extra(const f32x4 (&ax)[2], const Unit& u, int wr, int wc, int fr, int fq) const {
        const f32x4 s = ax[0] + ax[1];
        D[1048576 + ((size_t)(u.pm * 32 + u.pn) * 8 + wr * 4 + wc) * 64 + fq * 16 + fr] = s[0] + s[1] + s[2] + s[3];
    }
};
struct EpiUpConv {
    static constexpr bool WCOL = false, PDMA = true, PERM = true, PERMA = true, RIDE = false;
    bf16_t* G; const float* rss; const float* cw; const float* cb; const float* past; float* HB; float* st_p; float* st_s; PG8_LAS float* xs;
    __device__ __forceinline__ void pdma(PG8_LAS unsigned char* xp, const Unit& u, int wid, int lane) const {
        if (wid < 4) { const float* src = (wid < 3 ? cw + (size_t)wid * UPW : cb) + (lane >> 5) * DFF + u.pn * HALF + (lane & 31) * 4;
            __builtin_amdgcn_global_load_lds((const unsigned*)src, (PG8_LAS unsigned*)(xp + wid * 1024), 16, 0, 0); }
        else if (wid == 4) { __builtin_amdgcn_global_load_lds((const unsigned*)(rss + u.pm * BM + lane * 4), (PG8_LAS unsigned*)(xp + 4096), 16, 0, 0); }
    }
    PG8_LAS unsigned char* xp;
    __device__ __forceinline__ void operator()(f32x4 (&acc)[2][2][4][2], const Unit& u, int wr, int wc, int fr, int fq) const {
        const bool samp = u.pm >= NP / BM;
        const int f0 = u.pn * HALF + wc * 32 + 8 * fq;
        f32x4 r4s[2];
#pragma unroll
        for (int ai = 0; ai < 2; ++ai) r4s[ai] = *(const PG8_LAS f32x4*)(xp + 4096 + (ai * HALF + wr * 64 + 4 * fr) * 4);
#pragma unroll
        for (int ai = 0; ai < 2; ++ai) { const f32x4 r4 = r4s[ai];
#pragma unroll
            for (int m = 0; m < 4; ++m) { const float rs = __builtin_amdgcn_rsqf(r4[m] * (1.0f / DM) + EPS);
#pragma unroll
                for (int bj = 0; bj < 2; ++bj) { acc[ai][bj][m][0] = acc[ai][bj][m][0] * rs; acc[ai][bj][m][1] = acc[ai][bj][m][1] * rs; } } }
        if (fr == 15) {
#pragma unroll
            for (int ai = 0; ai < 2; ++ai) { const int s = 2 * ai + wr;
#pragma unroll
                for (int bj = 0; bj < 2; ++bj)
#pragma unroll
                    for (int mm = 0; mm < 2; ++mm)
#pragma unroll
                        for (int n = 0; n < 2; ++n) *(PG8_LAS f32x4*)(xs + 4 * ((((((s * 4 + wc) * 4 + fq) * 2 + bj) * 2 + mm) * 2) + n)) = acc[ai][bj][2 + mm][n]; } }
        if (!samp) {
            if (wr == 0 && fr == 0) {
#pragma unroll
                for (int bj = 0; bj < 2; ++bj)
#pragma unroll
                    for (int mm = 0; mm < 2; ++mm)
#pragma unroll
                        for (int n = 0; n < 2; ++n) *(f32x4*)(HB + ((size_t)u.pm * 4 + mm) * UPW + bj * DFF + f0 + 4 * n) = acc[0][bj][mm][n]; }
            if (wr == 1 && fr == 15) {
#pragma unroll
                for (int bj = 0; bj < 2; ++bj)
#pragma unroll
                    for (int mm = 0; mm < 2; ++mm)
#pragma unroll
                        for (int n = 0; n < 2; ++n) { const f32x4 v = acc[1][bj][2 + mm][n]; *(f32x4*)(HB + ((size_t)u.pm * 4 + 2 + mm) * UPW + bj * DFF + f0 + 4 * n) = v;
                            if ((u.pm & 7) == 7) *(f32x4*)(st_p + ((size_t)(u.pm >> 3) * 2 + mm) * UPW + bj * DFF + f0 + 4 * n) = v; } }
        } else if (fr & 1) {
#pragma unroll
            for (int ai = 0; ai < 2; ++ai) { const int b = 32 * (u.pm - NP / BM) + 8 * (2 * ai + wr) + (fr >> 1);
#pragma unroll
                for (int bj = 0; bj < 2; ++bj)
#pragma unroll
                    for (int mm = 0; mm < 2; ++mm)
#pragma unroll
                        for (int n = 0; n < 2; ++n) *(f32x4*)(st_s + ((size_t)b * 2 + mm) * UPW + bj * DFF + f0 + 4 * n) = acc[ai][bj][2 + mm][n]; } }
        asm volatile("s_waitcnt lgkmcnt(0)" ::: "memory"); __builtin_amdgcn_s_barrier(); asm volatile("" ::: "memory");
        v2u olo[2][4];
#pragma unroll
        for (int n = 0; n < 2; ++n) {
            f32x4 w0[2], w1[2], w2[2], bb[2];
#pragma unroll
            for (int bj = 0; bj < 2; ++bj) { const int o = bj * 512 + (wc * 32 + 8 * fq + 4 * n) * 4; w0[bj] = *(const PG8_LAS f32x4*)(xp + o); w1[bj] = *(const PG8_LAS f32x4*)(xp + 1024 + o); w2[bj] = *(const PG8_LAS f32x4*)(xp + 2048 + o); bb[bj] = *(const PG8_LAS f32x4*)(xp + 3072 + o); }
#pragma unroll
            for (int ai = 0; ai < 2; ++ai) { const int s = 2 * ai + wr;
                f32x4 cc[2][4];
#pragma unroll
                for (int bj = 0; bj < 2; ++bj) {
                    f32x4 B2, B3;
                    if (s == 0) { B2 = (f32x4){0.f, 0.f, 0.f, 0.f}; B3 = B2; }
                    else { const int sp = s - 1; B2 = *(PG8_LAS f32x4*)(xs + 4 * ((((((sp * 4 + wc) * 4 + fq) * 2 + bj) * 2 + 0) * 2) + n)); B3 = *(PG8_LAS f32x4*)(xs + 4 * ((((((sp * 4 + wc) * 4 + fq) * 2 + bj) * 2 + 1) * 2) + n)); }
                    const f32x4 v0 = acc[ai][bj][0][n], v1 = acc[ai][bj][1][n], v2 = acc[ai][bj][2][n], v3 = acc[ai][bj][3][n];
                    f32x4 P2, P3;
#pragma unroll
                    for (int x = 0; x < 4; ++x) { P2[x] = dpp_shr1(B2[x], v2[x]); P3[x] = dpp_shr1(B3[x], v3[x]); }
                    cc[bj][0] = bb[bj] + w2[bj] * v0 + w1[bj] * P3 + w0[bj] * P2;
                    cc[bj][1] = bb[bj] + w2[bj] * v1 + w1[bj] * v0 + w0[bj] * P3;
                    if (samp) { const int b = 32 * (u.pm - NP / BM) + 8 * s + (fr >> 1);
                        const f32x4 S2 = *(const f32x4*)(past + ((size_t)b * 2 + 0) * UPW + bj * DFF + f0 + 4 * n), S3 = *(const f32x4*)(past + ((size_t)b * 2 + 1) * UPW + bj * DFF + f0 + 4 * n);
                        if (!(fr & 1)) { cc[bj][0] = bb[bj] + w2[bj] * v0 + w1[bj] * S3 + w0[bj] * S2; cc[bj][1] = bb[bj] + w2[bj] * v1 + w1[bj] * v0 + w0[bj] * S3; } }
                    cc[bj][2] = bb[bj] + w2[bj] * v2 + w1[bj] * v1 + w0[bj] * v0;
                    cc[bj][3] = bb[bj] + w2[bj] * v3 + w1[bj] * v2 + w0[bj] * v1; }
#pragma unroll
                for (int m = 0; m < 4; ++m) { const int row = u.pm * BM + ai * HALF + wr * 64 + 4 * fr + m;
                    const f32x2 oa = silu_mul2((f32x2){cc[0][m][0], cc[0][m][1]}, (f32x2){cc[1][m][0], cc[1][m][1]}), ob = silu_mul2((f32x2){cc[0][m][2], cc[0][m][3]}, (f32x2){cc[1][m][2], cc[1][m][3]});
                    if (n == 0) { olo[ai][m].x = cvt_pk_bf16(oa.x, oa.y); olo[ai][m].y = cvt_pk_bf16(ob.x, ob.y); }
                    else { u32x4 w; w.x = olo[ai][m].x; w.y = olo[ai][m].y; w.z = cvt_pk_bf16(oa.x, oa.y); w.w = cvt_pk_bf16(ob.x, ob.y); *(u32x4*)(G + (size_t)row * DFF + f0) = w; } } } }
    }
};

template <class Epi, class Sched, bool ALIGN_EPI = true>
__device__ __forceinline__ void gemm_phase(PG8_LAS unsigned char* lds, const Gemm g, const Sched& S, const Epi& E) {
    const int tid = tid_fresh(), wid = __builtin_amdgcn_readfirstlane(tid >> 6), lane = tid & 63, wr = wid >> 2, wc = wid & 3, fr = lane & 15, fq = lane >> 4;
    const int K = g.K, nt = K / BK;
    unsigned voffA[2], voffB[2];
#pragma unroll
    for (int i = 0; i < 2; ++i) { int R, C; stage_rc(tid * 16 + i * 8192, R, C); const int Rb = Epi::WCOL ? (64 * (R >> 5) + perm32(R & 31)) : (Epi::PERM ? ((R & ~31) + perm32(R & 31)) : R);
        const int Ra = Epi::PERMA ? ((R & 64) + 4 * (R & 15) + ((R >> 4) & 3)) : R;
        voffA[i] = (unsigned)(Ra * K + C) * 2u; voffB[i] = (unsigned)(Rb * K + C) * 2u; }
    const size_t kstep = (size_t)(BK * 2);
    const size_t hstep = (size_t)HALF * K * 2;
    const size_t tstep = 2 * hstep;
    const size_t bhstep = Epi::WCOL ? (size_t)32 * K * 2 : hstep;
    const unsigned ldsw = (unsigned)wid * 1024u;
    const int aoff = lds_byte(wr * 64 + fr, fq * 8), boff = lds_byte(wc * 32 + fr, fq * 8);
    const int bsw = Epi::RIDE ? wr : 0;
#define PG8_SA(b, h) (((b) * 2 + (h)) * HTB)
#define PG8_SB(b, h) ((4 + (b) * 2 + (h)) * HTB)
    const __amdgpu_buffer_rsrc_t rsA = __builtin_amdgcn_make_buffer_rsrc((void*)g.A, 0, 0x7ffffff0, 0x00020000), rsB = __builtin_amdgcn_make_buffer_rsrc((void*)g.Bt, 0, 0x7ffffff0, 0x00020000);
#define PG8_STAGE(bufoff, gbase, voff) do { const bool isA_ = ((const void*)(voff) == (const void*)voffA); \
        const unsigned so_ = (unsigned)((const char*)(gbase) - (isA_ ? (const char*)g.A : (const char*)g.Bt)); \
        _Pragma("unroll") for (int _i = 0; _i < 2; ++_i) { \
            if (isA_) __builtin_amdgcn_raw_ptr_buffer_load_lds(rsA, (PG8_LAS void*)(lds + (bufoff) + ldsw + _i * 8192), 16, (voff)[_i], so_, 0, 0); \
            else      __builtin_amdgcn_raw_ptr_buffer_load_lds(rsB, (PG8_LAS void*)(lds + (bufoff) + ldsw + _i * 8192), 16, (voff)[_i], so_, 0, 0); } } while (0)
#define PG8_LDA(dst, b, h) do { _Pragma("unroll") for (int m = 0; m < 4; ++m) _Pragma("unroll") for (int k = 0; k < 2; ++k) dst[m][k] = *(const PG8_LAS bf16x8*)(lds + PG8_SA(b, h) + aoff + m * 2048 + k * 1024); } while (0)
#define PG8_LDB(dst, b, h) do { _Pragma("unroll") for (int n = 0; n < 2; ++n) _Pragma("unroll") for (int k = 0; k < 2; ++k) dst[n][k] = *(const PG8_LAS bf16x8*)(lds + PG8_SB(b, 0) + ((h) ^ bsw) * HTB + boff + n * 2048 + k * 1024); } while (0)
#define PG8_MMA(ai, bj, At, Bt) do { __builtin_amdgcn_s_setprio(1); _Pragma("unroll") for (int m = 0; m < 4; ++m) _Pragma("unroll") for (int n = 0; n < 2; ++n) _Pragma("unroll") for (int k = 0; k < 2; ++k) \
        acc[ai][bj][m][n] = __builtin_amdgcn_mfma_f32_16x16x32_bf16(Bt[n][k], At[m][k], acc[ai][bj][m][n], 0, 0, 0); __builtin_amdgcn_s_setprio(0); } while (0)
#define PG8_WAIT_V(n) asm volatile("s_waitcnt vmcnt(" #n ")" ::: "memory")
#define PG8_WAIT_L(n) asm volatile("s_waitcnt lgkmcnt(" #n ")" ::: "memory")
#define PG8_BAR __builtin_amdgcn_s_barrier()
#define PG8_SCHED __builtin_amdgcn_sched_barrier(0)
    Unit cur, nxt; int ui = 0;
    if (!S.next(0, cur)) return;
    f32x4 acc[2][2][4][2];
#pragma unroll
    for (int a = 0; a < 2; ++a)
#pragma unroll
        for (int b = 0; b < 2; ++b)
#pragma unroll
            for (int m = 0; m < 4; ++m)
#pragma unroll
                for (int n = 0; n < 2; ++n) acc[a][b][m][n] = (f32x4){0.f, 0.f, 0.f, 0.f};
    bf16x8 At[4][2], B0[2][2], B1[2][2];
    const char* cA = (const char*)g.A + (size_t)cur.pm * tstep; const char* cB = (const char*)g.Bt + (size_t)cur.pn * tstep;
    f32x4 accx[2]; bf16x8 axf[2]; const unsigned xlane = (unsigned)(fr * K + 8 * fq) * 2u; unsigned xrow = 0;
#define PG8_XDMA(tile, xr) do { if (wid < 2) { const char* gp_ = (const char*)g.A + (size_t)(xr) + (size_t)(tile) * 128 + xlane + wid * 64; \
        __builtin_amdgcn_global_load_lds((const unsigned*)gp_, (PG8_LAS unsigned*)(lds + XS_OFF + ((tile) & 3) * 2048 + wid * 1024), 16, 0, 0); } } while (0)
    if constexpr (Epi::RIDE) { accx[0] = (f32x4){0.f, 0.f, 0.f, 0.f}; accx[1] = accx[0];
        xrow = (unsigned)(NP + 16 * cur.pm) * (unsigned)K * 2u; PG8_XDMA(0, xrow); PG8_XDMA(1, xrow); }
#define PG8_XMMA(Bs) do { _Pragma("unroll") for (int n = 0; n < 2; ++n) _Pragma("unroll") for (int k = 0; k < 2; ++k) accx[n] = __builtin_amdgcn_mfma_f32_16x16x32_bf16(Bs[n][k], axf[k], accx[n], 0, 0, 0); } while (0)
#define PG8_RIDE_LD(tt) do { if constexpr (Epi::RIDE) { \
        axf[0] = *(const PG8_LAS bf16x8*)(lds + XS_OFF + ((tt) & 3) * 2048 + lane * 16); axf[1] = *(const PG8_LAS bf16x8*)(lds + XS_OFF + ((tt) & 3) * 2048 + 1024 + lane * 16); } } while (0)
#define PG8_RIDE(tt) do { if constexpr (Epi::RIDE) { PG8_XMMA(B0); \
        const bool in_ = (tt) + 2 < nt; const unsigned xr_ = in_ ? xrow : (has_next ? (unsigned)(NP + 16 * nxt.pm) * (unsigned)K * 2u : xrow); const int ti_ = in_ ? (tt) + 2 : (tt) + 2 - nt; \
        PG8_XDMA(ti_, xr_); } } while (0)
    S.a_ready(cur);
    PG8_STAGE(PG8_SB(0, 0), cB, voffB); PG8_STAGE(PG8_SB(0, 1), cB + bhstep, voffB); PG8_STAGE(PG8_SA(0, 0), cA, voffA); PG8_STAGE(PG8_SA(0, 1), cA + hstep, voffA);
    if (wr == 1) PG8_BAR;
    PG8_WAIT_V(2); PG8_BAR;
    PG8_STAGE(PG8_SB(1, 0), cB + kstep, voffB); PG8_STAGE(PG8_SA(1, 0), cA + kstep, voffA); PG8_STAGE(PG8_SB(1, 1), cB + bhstep + kstep, voffB);
    PG8_WAIT_V(6); PG8_BAR;
    for (;;) {
        const bool has_next = S.next(ui + 1, nxt);
        const char* nA = has_next ? (const char*)g.A + (size_t)nxt.pm * tstep : cA; const char* nB = has_next ? (const char*)g.Bt + (size_t)nxt.pn * tstep : cB;
        for (int t = 0; t < nt; t += 2) {
            const bool last = (t == nt - 2);
            const char* a1 = cA + (size_t)(t + 1) * kstep;
            const char* a2 = last ? nA : cA + (size_t)(t + 2) * kstep; const char* b2 = last ? nB : cB + (size_t)(t + 2) * kstep;
            const char* a3 = a2 + kstep; const char* b3 = b2 + kstep;
            if (last && has_next) S.a_ready(nxt);
            if constexpr (Epi::PDMA) { if (last) E.pdma(lds + XP_OFF, cur, wid, lane); }
            PG8_LDB(B0, 0, 0); PG8_LDB(B1, 0, 1); PG8_SCHED; PG8_LDA(At, 0, 0); PG8_STAGE(PG8_SA(1, 1), a1 + hstep, voffA);
            PG8_WAIT_V(8); PG8_WAIT_L(0); PG8_BAR; PG8_MMA(0, 0, At, B0); PG8_MMA(0, 1, At, B1); PG8_BAR; PG8_SCHED;
            PG8_LDA(At, 0, 1); PG8_RIDE_LD(t); PG8_STAGE(PG8_SB(0, 0), b2, voffB); PG8_STAGE(PG8_SB(0, 1), b2 + bhstep, voffB); PG8_STAGE(PG8_SA(0, 0), a2, voffA);
            PG8_WAIT_V(8); PG8_WAIT_L(0); PG8_BAR; PG8_MMA(1, 0, At, B0); PG8_MMA(1, 1, At, B1); PG8_RIDE(t); PG8_BAR; PG8_SCHED;
            PG8_LDB(B0, 1, 0); PG8_LDB(B1, 1, 1); PG8_SCHED; PG8_LDA(At, 1, 0); PG8_STAGE(PG8_SA(0, 1), a2 + hstep, voffA);
            PG8_WAIT_V(8); PG8_WAIT_L(0); PG8_BAR; PG8_MMA(0, 0, At, B0); PG8_MMA(0, 1, At, B1); PG8_BAR; PG8_SCHED;
            PG8_LDA(At, 1, 1); PG8_RIDE_LD(t + 1); PG8_STAGE(PG8_SB(1, 0), b3, voffB); PG8_STAGE(PG8_SB(1, 1), b3 + bhstep, voffB); PG8_STAGE(PG8_SA(1, 0), a3, voffA);
            PG8_WAIT_V(8); PG8_WAIT_L(0); PG8_BAR; PG8_MMA(1, 0, At, B0); PG8_MMA(1, 1, At, B1); PG8_RIDE(t + 1); PG8_BAR; PG8_SCHED;
        }
        if constexpr (ALIGN_EPI) { if (wr == 0) PG8_BAR; }
        int fr_e = fr, fq_e = fq; asm volatile("" : "+v"(fr_e), "+v"(fq_e));
        if constexpr (Epi::RIDE) {
            if constexpr (Epi::FUSEX) E.fused(acc, accx, cur, wr, wc, fr_e, fq_e);
            else { E.extra(accx, cur, wr, wc, fr_e, fq_e); E(acc, cur, wr, wc, fr_e, fq_e); }
            accx[0] = (f32x4){0.f, 0.f, 0.f, 0.f}; accx[1] = accx[0]; if (has_next) xrow = (unsigned)(NP + 16 * nxt.pm) * (unsigned)K * 2u; }
        else E(acc, cur, wr, wc, fr_e, fq_e);
        S.done(cur);
        if (!has_next) break;
#pragma unroll
        for (int a = 0; a < 2; ++a)
#pragma unroll
            for (int b = 0; b < 2; ++b)
#pragma unroll
                for (int m = 0; m < 4; ++m)
#pragma unroll
                    for (int n = 0; n < 2; ++n) acc[a][b][m][n] = (f32x4){0.f, 0.f, 0.f, 0.f};
        cur = nxt; cA = nA; cB = nB; ++ui;
        if constexpr (ALIGN_EPI) { if (wr == 1) PG8_BAR; }
    }
    PG8_WAIT_V(0);
    if constexpr (!ALIGN_EPI) { if (wr == 0) PG8_BAR; }
    PG8_BAR;
#undef PG8_XMMA
#undef PG8_RIDE
#undef PG8_RIDE_LD
#undef PG8_XDMA
#undef PG8_SA
#undef PG8_SB
#undef PG8_STAGE
#undef PG8_LDA
#undef PG8_LDB
#undef PG8_MMA
#undef PG8_WAIT_V
#undef PG8_WAIT_L
#undef PG8_BAR
#undef PG8_SCHED
}
}

#define RLX_AGENT __ATOMIC_RELAXED, __HIP_MEMORY_SCOPE_AGENT
#define XB_TMO      128
#define XB_MISM     192
#define XB_XCNT(j)  (256  + 64 * (j))
#define XB_XSUB(j)  (1280 + 64 * (j))
#define XB_XGEN(j)  (2304 + 64 * (j))
#define XB_TOP      3328
#define XB_TOPGEN   3392
#define XCD_BAR_WORDS 3456
#define XB_SPIN_CAP (1u << 22)
__device__ __forceinline__ unsigned xb_ld(unsigned* p)              { return __hip_atomic_load(p, __ATOMIC_RELAXED, __HIP_MEMORY_SCOPE_AGENT); }
__device__ __forceinline__ unsigned xb_add(unsigned* p, unsigned v) { return __hip_atomic_fetch_add(p, v, __ATOMIC_RELAXED, __HIP_MEMORY_SCOPE_AGENT); }
__device__ __forceinline__ unsigned xb_xcc_id() { return (unsigned)__builtin_amdgcn_s_getreg((3 << 11) | 20) & 0xFu; }
#define XB_SPIN(cond, bar) do { unsigned _sp = 0; while (cond) { __builtin_amdgcn_s_sleep(1); \
    if ((++_sp & 255u) == 0u) { if (xb_ld(&(bar)[XB_TMO])) break; if (_sp > XB_SPIN_CAP) { atomicAdd(&(bar)[XB_TMO], 1u); break; } } } } while (0)
struct XcdBarrier { unsigned* bar; unsigned x; volatile LAS unsigned* st; };
__device__ __forceinline__ XcdBarrier xcd_barrier_post(unsigned* bar, volatile LAS unsigned* st) {
    XcdBarrier b; b.bar = bar; b.x = xb_xcc_id(); b.st = st;
    if (threadIdx.x == 0) { (void)xb_add(&bar[XB_XCNT(b.x)], 1u);
        if (b.x != (blockIdx.x & 7u) || gridDim.x != 256u) (void)xb_add(&bar[XB_MISM], 1u); }
    return b;
}
__device__ __forceinline__ void xcd_barrier_complete(unsigned* bar, unsigned x, unsigned& nloc, unsigned& nx) {
    const unsigned G = gridDim.x * gridDim.y * gridDim.z;
    unsigned sum, cnt, mine, sp = 0u;
    for (;;) {
        sum = 0u; cnt = 0u; mine = 0u;
#pragma unroll
        for (unsigned j = 0; j < 16; ++j) { const unsigned c = xb_ld(&bar[XB_XCNT(j)]); sum += c; cnt += (c > 0u) ? 1u : 0u; mine = (j == x) ? c : mine; }
        if (sum == G) break;
        __builtin_amdgcn_s_sleep(1);
        if ((++sp & 255u) == 0u) { if (xb_ld(&bar[XB_TMO])) break; if (sp > XB_SPIN_CAP) { atomicAdd(&bar[XB_TMO], 1u); break; } }
    }
    nloc = mine > 0u ? mine : 1u; nx = cnt > 0u ? cnt : 1u;
}
__device__ __forceinline__ void xcd_barrier(const XcdBarrier& b, bool local = false) {
    asm volatile("s_waitcnt vmcnt(0)" ::: "memory");
    __syncthreads();
    if (threadIdx.x == 0) {
        unsigned* bar = b.bar;
        __builtin_amdgcn_s_waitcnt(0);
        unsigned nloc = b.st[0], nx = b.st[1];
        if (nloc == 0u) { xcd_barrier_complete(bar, b.x, nloc, nx); b.st[0] = nloc; b.st[1] = nx; }
        const bool lt = local && b.st[2] != 0u;
        const unsigned old = xb_add(&bar[XB_XSUB(b.x)], 1u);
        const unsigned gen = old / nloc;
        if (old + 1u == (gen + 1u) * nloc) {
            if (!lt) {
                __builtin_amdgcn_fence(__ATOMIC_RELEASE, "agent");
                asm volatile("s_waitcnt vmcnt(0)" ::: "memory");
                const unsigned og = xb_add(&bar[XB_TOP], 1u);
                const unsigned tg = og / nx;
                asm volatile("buffer_inv sc1" ::: "memory");
                if (og + 1u == (tg + 1u) * nx) xb_add(&bar[XB_TOPGEN], 1u);
                else XB_SPIN(xb_ld(&bar[XB_TOPGEN]) == tg, bar);
                asm volatile("s_waitcnt vmcnt(0)" ::: "memory");
            } else asm volatile("buffer_inv sc0" ::: "memory");
            xb_add(&bar[XB_XGEN(b.x)], 1u);
            asm volatile("s_waitcnt vmcnt(0)" ::: "memory");
        } else {
            asm volatile("buffer_inv sc0" ::: "memory");
            XB_SPIN(xb_ld(&bar[XB_XGEN(b.x)]) == gen, bar);
            asm volatile("s_waitcnt vmcnt(0)" ::: "memory");
        }
    }
    __syncthreads();
}

struct Args { const float* in[22]; float* out; unsigned char* ws; };
typedef const __attribute__((address_space(4))) char* kptr_t;
__device__ __forceinline__ const void* karg(int byte_off) { kptr_t kp = (kptr_t)__builtin_amdgcn_kernarg_segment_ptr(); return *(const void* const volatile __attribute__((address_space(4)))*)(kp + byte_off); }
#define KIN(k) ((const float*)karg(8 * (k)))
#define KOUT ((float*)karg(176))
#define KWS ((unsigned char*)karg(184))
struct Frame {
    LAS unsigned char* lds; int tid, lane, wave, vcu, G;
};
__device__ __forceinline__ float wave_sum(float v) {
#pragma unroll
    for (int o = 1; o < 64; o <<= 1) v += __shfl_xor(v, o);
    return v;
}

__device__ __forceinline__ int up_row(int n) { const int f = n < DFF ? n : n - DFF; return (f >> 7) * 256 + (n < DFF ? 0 : 128) + (f & 127); }
__device__ __forceinline__ int qkv_row(int n0) { if (n0 >= 1280) return n0; const int h = n0 >> 6, half = (n0 >> 5) & 1; return (h >> 2) * 256 + half * 128 + (h & 3) * 32; }
struct TMat { const float* W; int K, N; bf16* WT; const float* gk; int rowmap; };
struct TItem { f32x4 v[8]; float gv[8]; };
__device__ __forceinline__ void titem_load(TItem& t, const TMat& m, int item, int lane) {
    const int nblk = m.N / 32, kb = item / nblk, nb = item % nblk, k0 = 64 * kb, n0 = 32 * nb;
    const int lk = lane >> 3, ln = 4 * (lane & 7);
#pragma unroll
    for (int i = 0; i < 8; ++i) t.v[i] = *(const f32x4*)(m.W + (size_t)(k0 + 8 * i + lk) * m.N + n0 + ln);
    const float* gp = m.gk ? m.gk : m.W;
#pragma unroll
    for (int i = 0; i < 8; ++i) t.gv[i] = gp[k0 + 8 * i + lk];
}
__device__ __forceinline__ void titem_finish(const TItem& t, const TMat& m, LAS float* scr, int item, int lane) {
    const int nblk = m.N / 32, kb = item / nblk, nb = item % nblk, k0 = 64 * kb, n0 = 32 * nb;
    const int lk = lane >> 3, ln = 4 * (lane & 7);
#pragma unroll
    for (int i = 0; i < 8; ++i) { const int kk = 8 * i + lk; f32x4 x = t.v[i]; x = x * (m.gk ? t.gv[i] : 1.0f);
        LAS float* d = scr + kk * 33 + ln; d[0] = x[0]; d[1] = x[1]; d[2] = x[2]; d[3] = x[3]; }
    asm volatile("s_waitcnt lgkmcnt(0)" ::: "memory");
    const int c = lane & 7; const int r0 = m.rowmap == 1 ? up_row(n0) : (m.rowmap == 2 ? qkv_row(n0) : n0);
#pragma unroll
    for (int j = 0; j < 4; ++j) { const int n = (lane >> 3) + 8 * j; const LAS float* s = scr + (8 * c) * 33 + n;
        v4u o; o.x = pk2(s[0 * 33], s[1 * 33]); o.y = pk2(s[2 * 33], s[3 * 33]); o.z = pk2(s[4 * 33], s[5 * 33]); o.w = pk2(s[6 * 33], s[7 * 33]);
        *(GAS v4u*)(m.WT + (size_t)(r0 + n) * m.K + k0 + 8 * c) = o; }
    asm volatile("s_waitcnt lgkmcnt(0)" ::: "memory");
}
__device__ const double INVF[32] = {
    1.0, 0.7498942093324559, 0.5623413251903491, 0.4216965034285822, 0.31622776601683794, 0.23713737056616552, 0.1778279410038923, 0.1333521432163324,
    0.1, 0.07498942093324558, 0.05623413251903491, 0.042169650342858224, 0.03162277660168379, 0.023713737056616554, 0.01778279410038923, 0.01333521432163324,
    0.01, 0.007498942093324558, 0.005623413251903491, 0.004216965034285823, 0.0031622776601683794, 0.0023713737056616554, 0.0017782794100389228, 0.001333521432163324,
    0.001, 0.0007498942093324559, 0.0005623413251903491, 0.00042169650342858224, 0.00031622776601683794, 0.00023713737056616554, 0.00017782794100389227, 0.0001333521432163324};


__device__ __forceinline__ int cg_total(int group) {
    constexpr int I_IN = 16 * 128, I_OUT = 32 * 32, I_UP = 16 * 176, I_DN = 44 * 32, I_QKV = 16 * 48, I_O = 16 * 32;
    return group == 0 ? I_UP + I_IN + I_OUT : (group == 1 ? I_DN + I_QKV : I_UP + I_DN + I_O);
}
__device__ __forceinline__ int cg_mat(int group, int it, TMat& m) {
    unsigned char* ws = KWS;
    constexpr int I_IN = 16 * 128, I_UP = 16 * 176, I_DN = 44 * 32;
    int r = it;
    if (group == 0) {
        if (r < I_UP) { m = TMat{KIN(18), DM, UPW, (bf16*)(ws + WS_WUP0), KIN(17), 1}; return r; } r -= I_UP;
        if (r < I_IN) { m = TMat{KIN(6), DM, 4096, (bf16*)(ws + WS_WIN), nullptr, 0}; return r; } r -= I_IN;
        m = TMat{KIN(11), SW, DM, (bf16*)(ws + WS_WOUT), nullptr, 0}; return r;
    } else if (group == 1) {
        if (r < I_DN) { m = TMat{KIN(21), DFF, DM, (bf16*)(ws + WS_WDN0), nullptr, 0}; return r; } r -= I_DN;
        m = TMat{KIN(12), DM, QKVW, (bf16*)(ws + WS_WQKV), KIN(5) + DM, 2}; return r;
    } else {
        if (r < I_UP) { m = TMat{KIN(18) + (size_t)DM * UPW, DM, UPW, (bf16*)(ws + WS_WUP1), KIN(17) + DM, 1}; return r; } r -= I_UP;
        if (r < I_DN) { m = TMat{KIN(21) + (size_t)DFF * DM, DFF, DM, (bf16*)(ws + WS_WDN1), nullptr, 0}; return r; } r -= I_DN;
        m = TMat{KIN(16), DM, DM, (bf16*)(ws + WS_WO), nullptr, 0}; return r;
    }
}
template <bool PAIR>
__device__ __forceinline__ void convert_group(int group, int w0, int nw, LAS unsigned char* lds, int wave, int lane) {
    LAS float* scr = (LAS float*)(lds + wave * 16384);
    const int total = cg_total(group);
    if (PAIR) {
        for (int it = w0; it < total; it += 2 * nw) {
            const bool hb = it + nw < total; const int itb = hb ? it + nw : it;
            TMat ma, mb; const int ra = cg_mat(group, it, ma), rb = cg_mat(group, itb, mb);
            TItem ta, tb; titem_load(ta, ma, ra, lane); titem_load(tb, mb, rb, lane);
            titem_finish(ta, ma, scr, ra, lane);
            if (hb) titem_finish(tb, mb, scr, rb, lane);
        }
    } else {
        for (int it = w0; it < total; it += nw) { TMat ma; const int ra = cg_mat(group, it, ma); TItem ta; titem_load(ta, ma, ra, lane); titem_finish(ta, ma, scr, ra, lane); }
    }
}


__device__ __forceinline__ void copy_old_cache(int i0, int i1, int t0, int nthr) {
    float* out = KOUT; const float* cache_k = KIN(2); const float* cache_v = KIN(3);
    for (int i = i0 + t0; i < i1; i += 4 * nthr) {
        f32x4 kk[4], vv[4]; size_t oo[4];
#pragma unroll
        for (int j = 0; j < 4; ++j) { int ii = i + j * nthr; if (ii >= i1) ii = i; const int c4 = ii & 63, r = ii >> 6, w = r % 120, b = r / 120; oo[j] = ((size_t)b * 128 + w) * 256 + c4 * 4;
            kk[j] = *(const f32x4*)(cache_k + oo[j] + 8 * 256); vv[j] = *(const f32x4*)(cache_v + oo[j] + 8 * 256); }
#pragma unroll
        for (int j = 0; j < 4; ++j) { *(f32x4*)(out + O_CKS + oo[j]) = kk[j]; *(f32x4*)(out + O_CVS + oo[j]) = vv[j]; } }
}
constexpr int COPY_ITEMS = NBS * 120 * 64, COPY_SPLIT = (COPY_ITEMS / 10) * 6;

__device__ __forceinline__ int crow(int r, int hi) { return (r & 3) + 8 * (r >> 2) + 4 * hi; }
__device__ __forceinline__ bf16x8 packp(const f32x16& p, int s) {
    v4u w; w.x = cvt_pk_bf16(p[8 * s + 0], p[8 * s + 1]); w.y = cvt_pk_bf16(p[8 * s + 2], p[8 * s + 3]); w.z = cvt_pk_bf16(p[8 * s + 4], p[8 * s + 5]); w.w = cvt_pk_bf16(p[8 * s + 6], p[8 * s + 7]);
    return __builtin_bit_cast(bf16x8, w);
}
__device__ __forceinline__ void softmax5(f32x16 (&p)[5], float sink_l2) {
    float m = sink_l2;
#pragma unroll
    for (int kt = 0; kt < 5; ++kt)
#pragma unroll
        for (int r = 0; r < 16; ++r) m = fmaxf(m, p[kt][r]);
    m = fmaxf(m, __shfl_xor(m, 32));
    float sum = 0.f;
#pragma unroll
    for (int kt = 0; kt < 5; ++kt)
#pragma unroll
        for (int r = 0; r < 16; ++r) { const float e = __builtin_amdgcn_exp2f(p[kt][r] - m); p[kt][r] = e; sum += e; }
    sum += __shfl_xor(sum, 32);
    const float rden = 1.0f / (sum + __builtin_amdgcn_exp2f(sink_l2 - m));
#pragma unroll
    for (int kt = 0; kt < 5; ++kt)
#pragma unroll
        for (int r = 0; r < 16; ++r) p[kt][r] *= rden;
}

constexpr int A_KST = 144, A_VST = 520, A_KOFF = 0, A_VOFF = 256 * A_KST, A_OOFF = A_VOFF + 64 * A_VST;
__device__ __forceinline__ void attn_unit_load(v4u (&kr)[4], v4u (&vr)[4], const bf16* Kn, const bf16* Vt, int b, int kvh, int qblk, int tid) {
#pragma unroll
    for (int i = 0; i < 4; ++i) { const int c = tid + 512 * i;
        { const int key = c >> 3, ch = c & 7; int pos = 128 * (qblk - 1) + key; if (pos < 0) pos = 0; kr[i] = *(const v4u*)(Kn + ((size_t)b * SEQ + pos) * 256 + kvh * HD + ch * 8); }
        { const int d = c >> 5, kc = c & 31; int pos = 128 * (qblk - 1) + 8 * kc; if (pos < 0) pos = 0; vr[i] = *(const v4u*)(Vt + ((size_t)(b * NKV + kvh) * HD + d) * SEQ + pos); } }
}
__device__ __forceinline__ void attn_unit_store(LAS unsigned char* lds, const v4u (&kr)[4], const v4u (&vr)[4], int tid) {
#pragma unroll
    for (int i = 0; i < 4; ++i) { const int c = tid + 512 * i;
        *(LAS v4u*)(lds + A_KOFF + (c >> 3) * A_KST + (c & 7) * 16) = kr[i];
        LAS v2u* vp = (LAS v2u*)(lds + A_VOFF + (c >> 5) * A_VST + (c & 31) * 16); vp[0] = (v2u){vr[i].x, vr[i].y}; vp[1] = (v2u){vr[i].z, vr[i].w}; }
}
__device__ __forceinline__ void attn_q_load(bf16x8 (&qf)[4], const bf16* Q, int b, int h, int qblk, int q0s, int lane) {
    const int r32 = lane & 31, hi = lane >> 5;
    const size_t qrow = (size_t)b * SEQ + 128 * qblk + q0s + r32;
#pragma unroll
    for (int d0 = 0; d0 < 4; ++d0) qf[d0] = *(const bf16x8*)(Q + qrow * DM + h * HD + 16 * d0 + 8 * hi);
}
__device__ __forceinline__ void attn_sub_lds(LAS unsigned char* lds, const bf16x8 (&qf)[4], bf16* O, float sink_l2, int b, int h, int qblk, int q0s, int wave, int lane) {
    const int r32 = lane & 31, hi = lane >> 5;
    f32x16 p[5];
#pragma unroll
    for (int kt = 0; kt < 5; ++kt) {
        const LAS unsigned char* kp = lds + A_KOFF + (q0s + 32 * kt + r32) * A_KST + 16 * hi;
        p[kt] = (f32x16){0.f, 0.f, 0.f, 0.f, 0.f, 0.f, 0.f, 0.f, 0.f, 0.f, 0.f, 0.f, 0.f, 0.f, 0.f, 0.f};
#pragma unroll
        for (int d0 = 0; d0 < 4; ++d0) { const bf16x8 kf = *(const LAS bf16x8*)(kp + 32 * d0); p[kt] = __builtin_amdgcn_mfma_f32_32x32x16_bf16(kf, qf[d0], p[kt], 0, 0, 0); }
    }
    { const int a = r32 - 4 * hi;
#pragma unroll
        for (int r = 0; r < 16; ++r) { const int c0 = (r & 3) + 8 * (r >> 2); if (!(c0 > a)) p[0][r] = -INFINITY; if (!(c0 <= a)) p[4][r] = -INFINITY; }
        if (qblk == 0) {
#pragma unroll
            for (int kt = 0; kt < 4; ++kt) if (q0s + 32 * kt < 128) {
#pragma unroll
                for (int r = 0; r < 16; ++r) p[kt][r] = -INFINITY; } } }
    softmax5(p, sink_l2);
    f32x16 o[2];
#pragma unroll
    for (int d0 = 0; d0 < 2; ++d0) {
        o[d0] = (f32x16){0.f, 0.f, 0.f, 0.f, 0.f, 0.f, 0.f, 0.f, 0.f, 0.f, 0.f, 0.f, 0.f, 0.f, 0.f, 0.f};
        const LAS unsigned char* vp = lds + A_VOFF + (32 * d0 + r32) * A_VST + (q0s + 4 * hi) * 2;
#pragma unroll
        for (int kt = 0; kt < 5; ++kt)
#pragma unroll
            for (int s = 0; s < 2; ++s) { const v2u lo = *(const LAS v2u*)(vp + (32 * kt + 16 * s) * 2), hh = *(const LAS v2u*)(vp + (32 * kt + 16 * s + 8) * 2);
                v4u w; w.x = lo.x; w.y = lo.y; w.z = hh.x; w.w = hh.y;
                o[d0] = __builtin_amdgcn_mfma_f32_32x32x16_bf16(packp(p[kt], s), __builtin_bit_cast(bf16x8, w), o[d0], 0, 0, 0); }
    }
    LAS bf16* stg = (LAS bf16*)(lds + A_OOFF + wave * 4096);
#pragma unroll
    for (int d0 = 0; d0 < 2; ++d0)
#pragma unroll
        for (int r = 0; r < 16; ++r) stg[crow(r, hi) * 64 + 32 * d0 + r32] = (bf16)f2bf(o[d0][r]);
    asm volatile("s_waitcnt lgkmcnt(0)" ::: "memory");
#pragma unroll
    for (int i = 0; i < 4; ++i) { const int row = 8 * i + (lane >> 3), ch = lane & 7; const v4u v = *(const LAS v4u*)(stg + row * 64 + ch * 8);
        *(v4u*)(O + ((size_t)b * SEQ + 128 * qblk + q0s + row) * DM + h * HD + ch * 8) = v; }
    asm volatile("s_waitcnt lgkmcnt(0)" ::: "memory");
}

__device__ __forceinline__ void attn_sample_unit(const bf16* Qn, const bf16* Kn, const bf16* QKV, const float* ck, const float* cv, bf16* O, const float* sinks, int b, int kvh, int lane) {
    const int r32 = lane & 31, hi = lane >> 5, hh = r32 >> 3, qi = r32 & 7, h = 4 * kvh + hh;
    const size_t trow = (size_t)NP + 8 * b + qi;
    bf16x8 qf[4];
#pragma unroll
    for (int d0 = 0; d0 < 4; ++d0) qf[d0] = *(const bf16x8*)(Qn + trow * DM + h * HD + 16 * d0 + 8 * hi);
    f32x16 p[5];
#pragma unroll
    for (int kt = 0; kt < 4; ++kt) {
        const float* kr = ck + (((size_t)b * 128 + 32 * kt + r32) * NKV + kvh) * HD + 8 * hi;
        p[kt] = (f32x16){0.f, 0.f, 0.f, 0.f, 0.f, 0.f, 0.f, 0.f, 0.f, 0.f, 0.f, 0.f, 0.f, 0.f, 0.f, 0.f};
#pragma unroll
        for (int d0 = 0; d0 < 4; ++d0) { const f32x4 a = *(const f32x4*)(kr + 16 * d0), c = *(const f32x4*)(kr + 16 * d0 + 4);
            v4u w; w.x = pk2(a[0], a[1]); w.y = pk2(a[2], a[3]); w.z = pk2(c[0], c[1]); w.w = pk2(c[2], c[3]);
            p[kt] = __builtin_amdgcn_mfma_f32_32x32x16_bf16(__builtin_bit_cast(bf16x8, w), qf[d0], p[kt], 0, 0, 0); }
    }
    {
        const bf16* kr = Kn + ((size_t)NP + 8 * b + (r32 & 7)) * 256 + kvh * HD + 8 * hi;
        p[4] = (f32x16){0.f, 0.f, 0.f, 0.f, 0.f, 0.f, 0.f, 0.f, 0.f, 0.f, 0.f, 0.f, 0.f, 0.f, 0.f, 0.f};
#pragma unroll
        for (int d0 = 0; d0 < 4; ++d0) { v4u w = *(const v4u*)(kr + 16 * d0); if (r32 >= 8) w = (v4u){0u, 0u, 0u, 0u};
            p[4] = __builtin_amdgcn_mfma_f32_32x32x16_bf16(__builtin_bit_cast(bf16x8, w), qf[d0], p[4], 0, 0, 0); }
    }
    { const int a = qi - 4 * hi;
#pragma unroll
        for (int r = 0; r < 4; ++r) { if (!(r > a)) p[0][r] = -INFINITY; if (!(r <= a)) p[4][r] = -INFINITY; }
#pragma unroll
        for (int r = 4; r < 16; ++r) p[4][r] = -INFINITY; }
    softmax5(p, sinks[h] * LOG2E);
    f32x16 o[2];
#pragma unroll
    for (int d0 = 0; d0 < 2; ++d0) {
        o[d0] = (f32x16){0.f, 0.f, 0.f, 0.f, 0.f, 0.f, 0.f, 0.f, 0.f, 0.f, 0.f, 0.f, 0.f, 0.f, 0.f, 0.f};
#pragma unroll
        for (int kt = 0; kt < 4; ++kt)
#pragma unroll
            for (int s = 0; s < 2; ++s) {
                const float* vr = cv + (((size_t)b * 128 + 32 * kt + 16 * s + 4 * hi) * NKV + kvh) * HD + 32 * d0 + r32;
                float e[8];
#pragma unroll
                for (int j = 0; j < 8; ++j) e[j] = vr[(size_t)(8 * (j >> 2) + (j & 3)) * NKV * HD];
                v4u w; w.x = pk2(e[0], e[1]); w.y = pk2(e[2], e[3]); w.z = pk2(e[4], e[5]); w.w = pk2(e[6], e[7]);
                o[d0] = __builtin_amdgcn_mfma_f32_32x32x16_bf16(packp(p[kt], s), __builtin_bit_cast(bf16x8, w), o[d0], 0, 0, 0); }
        {
            const bf16* vr = QKV + ((size_t)8 * b + 4 * hi) * 256 + kvh * HD + 32 * d0 + r32;
            v4u w; w.x = (unsigned)vr[0] | ((unsigned)vr[256] << 16); w.y = (unsigned)vr[512] | ((unsigned)vr[768] << 16); w.z = 0u; w.w = 0u;
            o[d0] = __builtin_amdgcn_mfma_f32_32x32x16_bf16(packp(p[4], 0), __builtin_bit_cast(bf16x8, w), o[d0], 0, 0, 0); }
    }
#pragma unroll
    for (int d0 = 0; d0 < 2; ++d0)
#pragma unroll
        for (int r = 0; r < 16; ++r) { const int cr = crow(r, hi); O[((size_t)NP + 8 * b + (cr & 7)) * DM + (4 * kvh + (cr >> 3)) * HD + 32 * d0 + r32] = (bf16)f2bf(o[d0][r]); }
}


constexpr int AS_KST = 144, AS_VST = 328, AS_UNIT = 160 * AS_KST + 64 * AS_VST, AS_OOFF = 2 * AS_UNIT;
__device__ __forceinline__ void attn_sample_stage(LAS unsigned char* lds, const bf16* Kn, const bf16* Vs, const float* ck, const float* cv, int b, int kvh, int tid) {
#pragma unroll
    for (int i = 0; i < 4; ++i) { const int c = tid + 512 * i, key = c >> 4, d4 = c & 15;
        const f32x4 kx = *(const f32x4*)(ck + (((size_t)b * 128 + key) * NKV + kvh) * HD + 4 * d4), vx = *(const f32x4*)(cv + (((size_t)b * 128 + key) * NKV + kvh) * HD + 4 * d4);
        *(LAS v2u*)(lds + key * AS_KST + d4 * 8) = (v2u){pk2(kx[0], kx[1]), pk2(kx[2], kx[3])};
        LAS bf16* vp = (LAS bf16*)(lds + 160 * AS_KST + (4 * d4) * AS_VST) + key; const unsigned w0 = pk2(vx[0], vx[1]), w1 = pk2(vx[2], vx[3]);
        vp[0] = (bf16)(w0 & 0xffffu); vp[AS_VST / 2] = (bf16)(w0 >> 16); vp[2 * (AS_VST / 2)] = (bf16)(w1 & 0xffffu); vp[3 * (AS_VST / 2)] = (bf16)(w1 >> 16); }
    if (tid < 64) { const int j = tid >> 3, ch = tid & 7; *(LAS v4u*)(lds + (128 + j) * AS_KST + ch * 16) = *(const v4u*)(Kn + ((size_t)NP + 8 * b + j) * 256 + kvh * HD + ch * 8); }
    else if (tid < 64 + 216) { const int z = tid - 64; *(LAS v4u*)(lds + 136 * AS_KST + z * 16) = (v4u){0u, 0u, 0u, 0u}; }
    { const int j = tid >> 6, d = tid & 63; ((LAS bf16*)(lds + 160 * AS_KST + d * AS_VST))[128 + j] = Vs[((size_t)8 * b + j) * 256 + kvh * HD + d]; }
    if (tid < 384) { const int d = tid / 6, q = tid % 6; *(LAS v2u*)(lds + 160 * AS_KST + d * AS_VST + (136 + 4 * q) * 2) = (v2u){0u, 0u}; }
}
__device__ __forceinline__ void attn_sample_stage2(LAS unsigned char* lds, const bf16* Kn, const bf16* Vs, const float* ck, const float* cv, int b, int kvh0, int tid) {
    f32x4 kx[2][4], vx[2][4]; v4u nk[2]; bf16 nv[2];
#pragma unroll
    for (int uu = 0; uu < 2; ++uu) { const int kvh = kvh0 + uu;
#pragma unroll
        for (int i = 0; i < 4; ++i) { const int c = tid + 512 * i, key = c >> 4, d4 = c & 15;
            kx[uu][i] = *(const f32x4*)(ck + (((size_t)b * 128 + key) * NKV + kvh) * HD + 4 * d4); vx[uu][i] = *(const f32x4*)(cv + (((size_t)b * 128 + key) * NKV + kvh) * HD + 4 * d4); }
        { const int t6 = tid & 63, j = t6 >> 3, ch = t6 & 7; nk[uu] = *(const v4u*)(Kn + ((size_t)NP + 8 * b + j) * 256 + kvh * HD + ch * 8); }
        { const int j = tid >> 6, d = tid & 63; nv[uu] = Vs[((size_t)8 * b + j) * 256 + kvh * HD + d]; } }
#pragma unroll
    for (int uu = 0; uu < 2; ++uu) { LAS unsigned char* L = lds + uu * AS_UNIT;
#pragma unroll
        for (int i = 0; i < 4; ++i) { const int c = tid + 512 * i, key = c >> 4, d4 = c & 15; const f32x4 k4 = kx[uu][i], v4 = vx[uu][i];
            *(LAS v2u*)(L + key * AS_KST + d4 * 8) = (v2u){pk2(k4[0], k4[1]), pk2(k4[2], k4[3])};
            LAS bf16* vp = (LAS bf16*)(L + 160 * AS_KST + (4 * d4) * AS_VST) + key; const unsigned w0 = pk2(v4[0], v4[1]), w1 = pk2(v4[2], v4[3]);
            vp[0] = (bf16)(w0 & 0xffffu); vp[AS_VST / 2] = (bf16)(w0 >> 16); vp[2 * (AS_VST / 2)] = (bf16)(w1 & 0xffffu); vp[3 * (AS_VST / 2)] = (bf16)(w1 >> 16); }
        if (tid < 64) { const int j = tid >> 3, ch = tid & 7; *(LAS v4u*)(L + (128 + j) * AS_KST + ch * 16) = nk[uu]; }
        else if (tid < 64 + 216) { const int z = tid - 64; *(LAS v4u*)(L + 136 * AS_KST + z * 16) = (v4u){0u, 0u, 0u, 0u}; }
        { const int j = tid >> 6, d = tid & 63; ((LAS bf16*)(L + 160 * AS_KST + d * AS_VST))[128 + j] = nv[uu]; }
        if (tid < 384) { const int d = tid / 6, q = tid % 6; *(LAS v2u*)(L + 160 * AS_KST + d * AS_VST + (136 + 4 * q) * 2) = (v2u){0u, 0u}; } }
}
__device__ __forceinline__ void attn_sample_q(bf16x8 (&qf)[4], float& sl2, const bf16* Q, const float* sinks, int b, int kvh, int lane) {
    const int r32 = lane & 31, hi = lane >> 5, hh = r32 >> 3, qi = r32 & 7, h = 4 * kvh + hh;
    const size_t trow = (size_t)NP + 8 * b + qi;
#pragma unroll
    for (int d0 = 0; d0 < 4; ++d0) qf[d0] = *(const bf16x8*)(Q + trow * DM + h * HD + 16 * d0 + 8 * hi);
    sl2 = sinks[h] * LOG2E;
}
__device__ __forceinline__ void attn_sample_lds(LAS unsigned char* lds, LAS unsigned char* ostage, const bf16x8 (&qf)[4], float sl2, bf16* O, int b, int kvh, int lane) {
    const int r32 = lane & 31, hi = lane >> 5, qi = r32 & 7;
    f32x16 p[5];
#pragma unroll
    for (int kt = 0; kt < 5; ++kt) { const LAS unsigned char* kp = lds + (32 * kt + r32) * AS_KST + 16 * hi;
        p[kt] = (f32x16){0.f, 0.f, 0.f, 0.f, 0.f, 0.f, 0.f, 0.f, 0.f, 0.f, 0.f, 0.f, 0.f, 0.f, 0.f, 0.f};
#pragma unroll
        for (int d0 = 0; d0 < 4; ++d0) { const bf16x8 kf = *(const LAS bf16x8*)(kp + 32 * d0); p[kt] = __builtin_amdgcn_mfma_f32_32x32x16_bf16(kf, qf[d0], p[kt], 0, 0, 0); } }
    { const int a = qi - 4 * hi;
#pragma unroll
        for (int r = 0; r < 4; ++r) { if (!(r > a)) p[0][r] = -INFINITY; if (!(r <= a)) p[4][r] = -INFINITY; }
#pragma unroll
        for (int r = 4; r < 16; ++r) p[4][r] = -INFINITY; }
    softmax5(p, sl2);
    f32x16 o[2];
#pragma unroll
    for (int d0 = 0; d0 < 2; ++d0) {
        o[d0] = (f32x16){0.f, 0.f, 0.f, 0.f, 0.f, 0.f, 0.f, 0.f, 0.f, 0.f, 0.f, 0.f, 0.f, 0.f, 0.f, 0.f};
        const LAS unsigned char* vp = lds + 160 * AS_KST + (32 * d0 + r32) * AS_VST + (4 * hi) * 2;
#pragma unroll
        for (int kt = 0; kt < 5; ++kt)
#pragma unroll
            for (int s2 = 0; s2 < 2; ++s2) { const v2u lo = *(const LAS v2u*)(vp + (32 * kt + 16 * s2) * 2), hv = *(const LAS v2u*)(vp + (32 * kt + 16 * s2 + 8) * 2);
                v4u w; w.x = lo.x; w.y = lo.y; w.z = hv.x; w.w = hv.y;
                o[d0] = __builtin_amdgcn_mfma_f32_32x32x16_bf16(packp(p[kt], s2), __builtin_bit_cast(bf16x8, w), o[d0], 0, 0, 0); }
    }
    LAS bf16* stg = (LAS bf16*)ostage;
#pragma unroll
    for (int d0 = 0; d0 < 2; ++d0)
#pragma unroll
        for (int r = 0; r < 16; ++r) stg[crow(r, hi) * 64 + 32 * d0 + r32] = (bf16)f2bf(o[d0][r]);
    asm volatile("s_waitcnt lgkmcnt(0)" ::: "memory");
#pragma unroll
    for (int i = 0; i < 4; ++i) { const int row = 8 * i + (lane >> 3), ch = lane & 7; const v4u v = *(const LAS v4u*)(stg + row * 64 + ch * 8);
        *(v4u*)(O + ((size_t)NP + 8 * b + (row & 7)) * DM + (4 * kvh + (row >> 3)) * HD + ch * 8) = v; }
}

template <bool LAST>
__device__ __forceinline__ void mini_gemm_resid(const bf16* A, const bf16* Bt, int K, int job, const float* bb  , float* Y, bf16* XBo, float* rssq) {
    const int tid = tid_fresh(), lane = tid & 63, wave = __builtin_amdgcn_readfirstlane(tid >> 6), l15 = lane & 15, l4 = lane >> 4;
    const int rb = job >> 2, pn = job & 3, row = NP + 16 * rb + l15;
    const bf16* ap = A + (size_t)row * K + 8 * l4;
    const bf16* bp0 = Bt + (size_t)(256 * pn + 32 * wave + l15) * K + 8 * l4;
    const bf16* bp1 = bp0 + (size_t)16 * K;
    f32x4 acc0 = (f32x4){0.f, 0.f, 0.f, 0.f}, acc1 = acc0;
    bf16x8 a[4], b0[4], b1[4], an[4], b0n[4], b1n[4];
#pragma unroll
    for (int j = 0; j < 4; ++j) { a[j] = *(const bf16x8*)(ap + 32 * j); b0[j] = *(const bf16x8*)(bp0 + 32 * j); b1[j] = *(const bf16x8*)(bp1 + 32 * j); }
    for (int k0 = 128; k0 <= K; k0 += 128) {
        if (k0 < K) {
#pragma unroll
            for (int j = 0; j < 4; ++j) { an[j] = *(const bf16x8*)(ap + k0 + 32 * j); b0n[j] = *(const bf16x8*)(bp0 + k0 + 32 * j); b1n[j] = *(const bf16x8*)(bp1 + k0 + 32 * j); } }
#pragma unroll
        for (int j = 0; j < 4; ++j) { acc0 = __builtin_amdgcn_mfma_f32_16x16x32_bf16(b0[j], a[j], acc0, 0, 0, 0); acc1 = __builtin_amdgcn_mfma_f32_16x16x32_bf16(b1[j], a[j], acc1, 0, 0, 0); }
#pragma unroll
        for (int j = 0; j < 4; ++j) { a[j] = an[j]; b0[j] = b0n[j]; b1[j] = b1n[j]; }
    }
    float ss = 0.f;
#pragma unroll
    for (int nb = 0; nb < 2; ++nb) { const size_t off = (size_t)row * DM + 256 * pn + 32 * wave + 16 * nb + 4 * l4; const f32x4 o = *(const f32x4*)(bb + off) + (nb ? acc1 : acc0);
        *(f32x4*)(Y + off) = o;
        if (!LAST) { ss += o[0] * o[0] + o[1] * o[1] + o[2] * o[2] + o[3] * o[3]; v2u w; w.x = cvt_pk_bf16(o[0], o[1]); w.y = cvt_pk_bf16(o[2], o[3]); *(v2u*)(XBo + off) = w; } }
    if (!LAST) { ss += __shfl_xor(ss, 16); ss += __shfl_xor(ss, 32); if (l4 == 0) atomicAdd(rssq + row, ss); }
}

__global__ void __launch_bounds__(512, 2) fwd_mega(Args args) {
    extern __shared__ __attribute__((aligned(16))) unsigned char lds_raw[];
    LAS unsigned char* lds = (LAS unsigned char*)lds_raw;
    const int G = gridDim.x, bx = blockIdx.x;
#define PHASE_IDS const int tid = tid_fresh(), lane = tid & 63, wave = __builtin_amdgcn_readfirstlane(tid >> 6); const int gw = vcu * 8 + wave, NGW = G * 8, gt = bx * 512 + tid, NGT = G * 512; (void)lane; (void)wave; (void)gw; (void)NGW; (void)gt; (void)NGT;
    const int vcu = (G % 8 == 0) ? (bx % 8) * (G / 8) + bx / 8 : bx;
    gu32* ctl = (gu32*)(KWS + WS_CTL);
    volatile LAS unsigned* MISC = (volatile LAS unsigned*)(lds + MISC_OFF);
    { const int tid0 = tid_fresh(); for (int u = tid0; u < (LDS_BYTES - LDSCTL_OFF) / 4; u += 512) ((LAS unsigned*)(lds + LDSCTL_OFF))[u] = 0u; }
    __syncthreads();
    XcdBarrier bar = xcd_barrier_post((unsigned*)(ctl + CW_BAR), MISC + 8);
#define GRID_BAR() xcd_barrier(bar)
#define XCD_BAR()  xcd_barrier(bar, true)

    for (int rep = 0; rep < REP_P0; ++rep) {
        PHASE_IDS
        unsigned char* ws = KWS; const float* x_p = KIN(0); const float* x_s = KIN(1); const float* mix_g = KIN(5); const float* w_s = KIN(9);
        bf16* Wsb = (bf16*)(ws + WS_WSB); f32x2* rope = (f32x2*)(ws + WS_ROPE); bf16* XB = (bf16*)(ws + WS_XB);
        convert_group<true>(0, gw, NGW, lds, wave, lane);
        f32x4 gg4[4];
        { const GAS f32x4* gr = (const GAS f32x4*)mix_g + lane;
#pragma unroll
            for (int j = 0; j < 4; ++j) gg4[j] = gr[64 * j]; }
        for (int m0 = 2 * gw; m0 < T; m0 += 2 * NGW) {
            f32x4 v[2][4]; float s[2];
#pragma unroll
            for (int r = 0; r < 2; ++r) { const int m = m0 + r; const float* xrow = (m < NP) ? x_p + (size_t)m * DM : x_s + (size_t)(m - NP) * DM; const GAS f32x4* xr = (const GAS f32x4*)xrow + lane;
#pragma unroll
                for (int j = 0; j < 4; ++j) v[r][j] = xr[64 * j]; }
#pragma unroll
            for (int r = 0; r < 2; ++r) { s[r] = 0.f;
#pragma unroll
                for (int j = 0; j < 4; ++j) s[r] += (v[r][j].x * v[r][j].x + v[r][j].y * v[r][j].y) + (v[r][j].z * v[r][j].z + v[r][j].w * v[r][j].w); }
#pragma unroll
            for (int r = 0; r < 2; ++r) { const float rstd = 1.0f / sqrtf(wave_sum(s[r]) * (1.f / DM) + EPS);
                GAS unsigned long long* o8 = (GAS unsigned long long*)(XB + (size_t)(m0 + r) * DM) + lane;
#pragma unroll
                for (int j = 0; j < 4; ++j) { const f32x4 gg = gg4[j]; o8[64 * j] = (unsigned long long)pk2(v[r][j].x * rstd * gg.x, v[r][j].y * rstd * gg.y) | ((unsigned long long)pk2(v[r][j].z * rstd * gg.z, v[r][j].w * rstd * gg.w) << 32); } }
        }
        for (int i = gt; i < 8 * 128 * 128; i += NGT) { const int s = i & 127, t = (i >> 7) & 127; Wsb[i] = (bf16)f2bf(s <= t ? w_s[i] : 0.f); }
        for (int i = gt; i < 2056 * 32; i += NGT) { const int pi = i >> 5, fi = i & 31; const double pos = (pi < SEQ) ? (double)pi : (double)(PAST + pi - SEQ);
            const double rev = pos * INVF[fi] * 0.15915494309189535; const float fr_ = (float)(rev - floor(rev));
            rope[i] = (f32x2){__builtin_amdgcn_cosf(fr_), __builtin_amdgcn_sinf(fr_)}; }
    }
    GRID_BAR();
    if (threadIdx.x == 0) MISC[10] = (xb_ld((unsigned*)(ctl + CW_BAR) + XB_MISM) == 0u && G == 256) ? 1u : 0u;

    for (int rep = 0; rep < REP_P1; ++rep) {
        unsigned char* ws = KWS;
        pg8::Gemm g{(bf16*)(ws + WS_XB), (bf16*)(ws + WS_WIN), NP, 4096, DM}; pg8::StaticOrder S; S.init(NP, 4096, G, bx);
        pg8::EpiGelu E{(bf16*)(ws + WS_U), (bf16*)(ws + WS_V), (float*)(ws + (rep < REP_P1 - 1 ? (size_t)768 * 1024 : CTL_LNS))};
        pg8::gemm_phase<pg8::EpiGelu, pg8::StaticOrder>(lds, g, S, E);
    }
    XCD_BAR();

    for (int rep = 0; rep < REP_P2; ++rep) {
        PHASE_IDS
        unsigned char* ws = KWS; float* out = KOUT; const float* ln_g = KIN(7); const float* ln_b = KIN(8); const float* w_s = KIN(9); const float* b_s = KIN(10);
        bf16* Ub = (bf16*)(ws + WS_U); bf16* Vb = (bf16*)(ws + WS_V); bf16* Wsb = (bf16*)(ws + WS_WSB); float* lnS = (float*)(ws + CTL_LNS);
        bf16* Uo = (rep < REP_P2 - 1) ? (bf16*)out : Ub;
        constexpr int RS = 80, WTILE = 128 * RS, WOFF = 8 * WTILE;
        const int l15 = lane & 15, l4 = lane >> 4, rl = lane >> 2, q4 = lane & 3;
        LAS unsigned char* wt = lds + wave * WTILE;
        v4u vraw[8]; f32x2 vst[8];
#define MIX_LOAD(unit_) do { const int c_ = (unit_) >> 3, g_ = (unit_) & 7; _Pragma("unroll") for (int i = 0; i < 8; ++i) { const size_t row_ = (size_t)c_ * 128 + rl + 16 * i; \
            vraw[i] = *(const v4u*)(Vb + row_ * SW + g_ * 256 + 32 * wave + q4 * 8); vst[i] = *(const f32x2*)(lnS + 2 * row_); } } while (0)
        const bool xmap = (G == 256); const int xq = bx & 7, li = bx >> 3;
#define MIX_UNIT(k_) (xmap ? ((((16 * xq + (li >> 3) + 4 * (k_)) << 3)) | (li & 7)) : bx + (k_) * G)
        int uk = 0; int unit = MIX_UNIT(0);
        if (unit < 1024) MIX_LOAD(unit);
        constexpr bool g_fixed = true;
        if (g_fixed) { const int gfix = xmap ? (li & 7) : (bx & 7);
            v4u wst[4];
#pragma unroll
            for (int q = 0; q < 4; ++q) { const int f = 8 * q + wave, mb = f >> 2, kk = f & 3; wst[q] = *(const v4u*)(Wsb + ((size_t)(gfix * 128 + 16 * mb + l15)) * 128 + 32 * kk + 8 * l4); }
#pragma unroll
            for (int q = 0; q < 4; ++q) *(LAS v4u*)(lds + WOFF + (8 * q + wave) * 1024 + lane * 16) = wst[q]; }
        f32x4 g0, g1, b0, b1; float bsv[8];
#define MIX_PARAMS(g_) do { const int cq_ = (g_) * 256 + 32 * wave + q4 * 8; g0 = *(const f32x4*)(ln_g + cq_); g1 = *(const f32x4*)(ln_g + cq_ + 4); b0 = *(const f32x4*)(ln_b + cq_); b1 = *(const f32x4*)(ln_b + cq_ + 4); \
            _Pragma("unroll") for (int mb = 0; mb < 8; ++mb) bsv[mb] = b_s[(g_) * 128 + 16 * mb + l15]; } while (0)
        if (g_fixed) MIX_PARAMS(xmap ? (li & 7) : (bx & 7));
        __syncthreads();
        for (; unit < 1024 && (!xmap || uk < 4); unit = MIX_UNIT(uk)) {
            ++uk; const int unext = (xmap && uk >= 4) ? 1024 : MIX_UNIT(uk);
            const int c = unit >> 3, g = unit & 7, R0 = c * 128, chw = g * 256 + 32 * wave;
            if (!g_fixed) MIX_PARAMS(g);
            {
#pragma unroll
                for (int i = 0; i < 8; ++i) { const float mu = vst[i].x * (1.f / SW), var = vst[i].y * (1.f / SW) - mu * mu, rstd = __builtin_amdgcn_rsqf(var + EPS); const v4u raw = vraw[i];
                    v4u w; w.x = pk2((bflo(raw.x) - mu) * rstd * g0[0] + b0[0], (bfhi(raw.x) - mu) * rstd * g0[1] + b0[1]); w.y = pk2((bflo(raw.y) - mu) * rstd * g0[2] + b0[2], (bfhi(raw.y) - mu) * rstd * g0[3] + b0[3]);
                    w.z = pk2((bflo(raw.z) - mu) * rstd * g1[0] + b1[0], (bfhi(raw.z) - mu) * rstd * g1[1] + b1[1]); w.w = pk2((bflo(raw.w) - mu) * rstd * g1[2] + b1[2], (bfhi(raw.w) - mu) * rstd * g1[3] + b1[3]);
                    *(LAS v4u*)(wt + (rl + 16 * i) * RS + q4 * 16) = w; }
            }
            v4u uraw[8];
#pragma unroll
            for (int i = 0; i < 8; ++i) uraw[i] = *(const v4u*)(Ub + (size_t)(R0 + rl + 16 * i) * SW + chw + q4 * 8);
            if (unext < 1024) MIX_LOAD(unext);
            f32x4 acc[8][2];
#pragma unroll
            for (int mb = 0; mb < 8; ++mb) { acc[mb][0] = (f32x4){0.f, 0.f, 0.f, 0.f}; acc[mb][1] = acc[mb][0]; }
#pragma unroll
            for (int kk = 0; kk < 4; ++kk) {
                bf16x8 vf[2];
#pragma unroll
                for (int nb = 0; nb < 2; ++nb) { const LAS bf16* p = (const LAS bf16*)(wt + (32 * kk + 8 * l4) * RS) + 16 * nb + l15;
                    v4u w; w.x = (unsigned)p[0] | ((unsigned)p[RS / 2] << 16); w.y = (unsigned)p[2 * (RS / 2)] | ((unsigned)p[3 * (RS / 2)] << 16); w.z = (unsigned)p[4 * (RS / 2)] | ((unsigned)p[5 * (RS / 2)] << 16); w.w = (unsigned)p[6 * (RS / 2)] | ((unsigned)p[7 * (RS / 2)] << 16);
                    vf[nb] = __builtin_bit_cast(bf16x8, w); }
#pragma unroll
                for (int mb = 0; mb < 8; ++mb) { if (32 * kk > 16 * mb + 15) continue;
                    const bf16x8 wf = g_fixed ? *(const LAS bf16x8*)(lds + WOFF + (mb * 4 + kk) * 1024 + lane * 16) : *(const bf16x8*)(Wsb + ((size_t)(g * 128 + 16 * mb + l15)) * 128 + 32 * kk + 8 * l4);
                    acc[mb][0] = __builtin_amdgcn_mfma_f32_16x16x32_bf16(vf[0], wf, acc[mb][0], 0, 0, 0); acc[mb][1] = __builtin_amdgcn_mfma_f32_16x16x32_bf16(vf[1], wf, acc[mb][1], 0, 0, 0); } }
#pragma unroll
            for (int mb = 0; mb < 8; ++mb) { const int t = 16 * mb + l15; const float bs = bsv[mb];
#pragma unroll
                for (int nb = 0; nb < 2; ++nb) { v2u w; w.x = pk2(acc[mb][nb][0] + bs, acc[mb][nb][1] + bs); w.y = pk2(acc[mb][nb][2] + bs, acc[mb][nb][3] + bs);
                    *(LAS v2u*)(wt + t * RS + (16 * nb + 4 * l4) * 2) = w; } }
#pragma unroll
            for (int i = 0; i < 8; ++i) { const v4u mx = *(const LAS v4u*)(wt + (rl + 16 * i) * RS + q4 * 16); const v4u u4 = uraw[i];
                v4u w; w.x = pk2(bflo(u4.x) * bflo(mx.x), bfhi(u4.x) * bfhi(mx.x)); w.y = pk2(bflo(u4.y) * bflo(mx.y), bfhi(u4.y) * bfhi(mx.y));
                w.z = pk2(bflo(u4.z) * bflo(mx.z), bfhi(u4.z) * bfhi(mx.z)); w.w = pk2(bflo(u4.w) * bflo(mx.w), bfhi(u4.w) * bfhi(mx.w));
                *(v4u*)(Uo + (size_t)(R0 + rl + 16 * i) * SW + chw + q4 * 8) = w; }
        }
#undef MIX_LOAD
#undef MIX_PARAMS
#undef MIX_UNIT
        if (wave < 2) {
            for (int item0 = (2 * bx + wave) * 64 + lane; item0 < 32768; item0 += 2 * G * 64) {
                const int item = xmap ? (((16 * xq) << 8) + li * 128 + wave * 64 + lane) : item0;
                const int b = item >> 8, cs = item & 255, g = cs >> 5, ch0 = cs * 8; const size_t r0 = (size_t)NP + 8 * b;
                v4u vr[8], ur[8]; f32x2 st8[8]; f32x4 wa[8], wb[4];
#pragma unroll
                for (int t = 0; t < 8; ++t) { st8[t] = *(const f32x2*)(lnS + 2 * (r0 + t)); vr[t] = *(const v4u*)(Vb + (r0 + t) * SW + ch0); }
                const f32x4 g0 = *(const f32x4*)(ln_g + ch0), g1 = *(const f32x4*)(ln_g + ch0 + 4), b0 = *(const f32x4*)(ln_b + ch0), b1 = *(const f32x4*)(ln_b + ch0 + 4);
                const f32x4 bsa = *(const f32x4*)(b_s + g * 128), bsb = *(const f32x4*)(b_s + g * 128 + 4);
#pragma unroll
                for (int t = 0; t < 8; ++t) { wa[t] = *(const f32x4*)(w_s + (size_t)(g * 128 + t) * 128); if (t >= 4) wb[t - 4] = *(const f32x4*)(w_s + (size_t)(g * 128 + t) * 128 + 4); }
#pragma unroll
                for (int t = 0; t < 8; ++t) ur[t] = *(const v4u*)(Ub + (r0 + t) * SW + ch0);
                float vn[8][8];
#pragma unroll
                for (int t = 0; t < 8; ++t) { const float mu = st8[t].x * (1.f / SW), var = st8[t].y * (1.f / SW) - mu * mu, rstd = __builtin_amdgcn_rsqf(var + EPS);
                    const v4u raw = vr[t];
                    float y[8]; y[0] = bflo(raw.x); y[1] = bfhi(raw.x); y[2] = bflo(raw.y); y[3] = bfhi(raw.y); y[4] = bflo(raw.z); y[5] = bfhi(raw.z); y[6] = bflo(raw.w); y[7] = bfhi(raw.w);
#pragma unroll
                    for (int j = 0; j < 8; ++j) vn[t][j] = (y[j] - mu) * rstd * (j < 4 ? g0[j & 3] : g1[j & 3]) + (j < 4 ? b0[j & 3] : b1[j & 3]);
                    float* so = out + O_SGUV + (r0 - NP + t) * SW + ch0;
                    *(f32x4*)so = (f32x4){vn[t][0], vn[t][1], vn[t][2], vn[t][3]}; *(f32x4*)(so + 4) = (f32x4){vn[t][4], vn[t][5], vn[t][6], vn[t][7]}; }
#pragma unroll
                for (int t = 0; t < 8; ++t) { float mx[8]; const float bs = t < 4 ? bsa[t & 3] : bsb[t & 3];
#pragma unroll
                    for (int j = 0; j < 8; ++j) mx[j] = bs;
#pragma unroll
                    for (int s2 = 0; s2 <= t; ++s2) { const float w = s2 < 4 ? wa[t][s2 & 3] : wb[(t - 4) & 3][s2 & 3];
#pragma unroll
                        for (int j = 0; j < 8; ++j) mx[j] += w * vn[s2][j]; }
                    const v4u uu2 = ur[t]; bf16* up = Uo + (r0 + t) * SW + ch0;
                    v4u w; w.x = pk2(bflo(uu2.x) * mx[0], bfhi(uu2.x) * mx[1]); w.y = pk2(bflo(uu2.y) * mx[2], bfhi(uu2.y) * mx[3]); w.z = pk2(bflo(uu2.z) * mx[4], bfhi(uu2.z) * mx[5]); w.w = pk2(bflo(uu2.w) * mx[6], bfhi(uu2.w) * mx[7]);
                    *(v4u*)up = w; }
            }
        }
    }
    XCD_BAR();

#if PROBE_P3NULL
    {
        unsigned char* ws = KWS;
        pg8::Gemm g{(bf16*)(ws + WS_U), (bf16*)(ws + WS_WOUT), NP, DM, SW}; pg8::StaticOrder S; S.init(NP, DM, G, bx);
        pg8::EpiNull2<(PROBE_P3NULL == 2)> E{(float*)(KOUT)};
        pg8::gemm_phase<pg8::EpiNull2<(PROBE_P3NULL == 2)>, pg8::StaticOrder>(lds, g, S, E);
    }
#endif
    for (int rep = 0; rep < REP_P3; ++rep) {
        unsigned char* ws = KWS; float* out = KOUT;
        pg8::Gemm g{(bf16*)(ws + WS_U), (bf16*)(ws + WS_WOUT), NP, DM, SW}; pg8::StaticOrder S; S.init(NP, DM, G, bx);
        pg8::EpiResid<0> E{KIN(0), KIN(1), out + O_Y, (bf16*)(ws + WS_XB), (float*)(ws + (rep < REP_P3 - 1 ? (size_t)768 * 1024 : CTL_RSS))};
        pg8::gemm_phase<pg8::EpiResid<0>, pg8::StaticOrder>(lds, g, S, E);
    }
    GRID_BAR();

#define FFN_LAYER(L, RSS_IN, RSS_OUT, LASTF) \
    for (int rep4 = 0; rep4 < ((L) == 0 ? REP_P4 : 1); ++rep4) { \
        unsigned char* ws = KWS; float* out = KOUT; float* rss = (float*)(ws + CTL_RSS); (void)rss; \
        pg8::Gemm g{(bf16*)(ws + WS_XB), (bf16*)(ws + ((L) ? WS_WUP1 : WS_WUP0)), T, UPW, DM}; pg8::StaticOrder S; S.init(T, UPW, G, bx); \
        pg8::EpiUpConv E{(bf16*)(ws + WS_G), RSS_IN, KIN(19) + (size_t)(L) * 3 * UPW, KIN(20) + (size_t)(L) * UPW, KIN(4) + (size_t)(L) * NBS * 2 * UPW, (float*)(ws + WS_HB), out + O_STP + (size_t)(L) * NBP * 2 * UPW, out + O_STS + (size_t)(L) * NBS * 2 * UPW, (LAS float*)(lds + XS_OFF), lds + XP_OFF}; \
        pg8::gemm_phase<pg8::EpiUpConv, pg8::StaticOrder>(lds, g, S, E); \
        if ((L) == 0) { const int busy = ((T / 256) * (UPW / 256)) % G; if (bx >= busy) { PHASE_IDS convert_group<false>(1, (bx - busy) * 8 + wave, (G - busy) * 8, lds, wave, lane); } __syncthreads(); } \
        else { const int busy = ((T / 256) * (UPW / 256)) % G; if (bx >= busy) { PHASE_IDS copy_old_cache(COPY_SPLIT, COPY_ITEMS, (bx - busy) * 512 + tid, (G - busy) * 512); } } \
    } \
    GRID_BAR(); \
    { \
        unsigned char* ws = KWS; float* out = KOUT; float* rss = (float*)(ws + CTL_RSS); (void)rss; \
        pg8::Gemm g{(bf16*)(ws + WS_G), (bf16*)(ws + ((L) ? WS_WDN1 : WS_WDN0)), NP, DM, DFF}; pg8::StaticOrder S; S.init(NP, DM, G, bx); \
        {   \
            PHASE_IDS \
            float* HB = (float*)(ws + WS_HB); bf16* Gb = (bf16*)(ws + WS_G); const float* cw = KIN(19) + (size_t)(L) * 3 * UPW; const float* cb = KIN(20) + (size_t)(L) * UPW; \
            pg8::Unit fu; \
            for (int ui = 0; S.next(ui, fu); ++ui) { const int pm = fu.pm; if ((pm & 7) == 0) continue; \
                  \
                f32x4 hb[2][2][4], wv[2][2][4]; \
                _Pragma("unroll") for (int it = 0; it < 2; ++it) { const int f = (tid + it * 512) * 4; if (it == 0 || tid < 192) { \
                    _Pragma("unroll") for (int bj = 0; bj < 2; ++bj) { const int c = bj * DFF + f; \
                        hb[it][bj][0] = *(const f32x4*)(HB + ((size_t)(pm - 1) * 4 + 2) * UPW + c); hb[it][bj][1] = *(const f32x4*)(HB + ((size_t)(pm - 1) * 4 + 3) * UPW + c); \
                        hb[it][bj][2] = *(const f32x4*)(HB + ((size_t)pm * 4 + 0) * UPW + c); hb[it][bj][3] = *(const f32x4*)(HB + ((size_t)pm * 4 + 1) * UPW + c); \
                        wv[it][bj][0] = *(const f32x4*)(cw + c); wv[it][bj][1] = *(const f32x4*)(cw + UPW + c); wv[it][bj][2] = *(const f32x4*)(cw + 2 * UPW + c); wv[it][bj][3] = *(const f32x4*)(cb + c); } } } \
                _Pragma("unroll") for (int it = 0; it < 2; ++it) { const int f = (tid + it * 512) * 4; if (it == 0 || tid < 192) { \
                    _Pragma("unroll") for (int t = 0; t < 2; ++t) { f32x4 cc[2]; \
                        _Pragma("unroll") for (int bj = 0; bj < 2; ++bj) cc[bj] = wv[it][bj][3] + wv[it][bj][2] * hb[it][bj][2 + t] + wv[it][bj][1] * hb[it][bj][1 + t] + wv[it][bj][0] * hb[it][bj][t]; \
                        f32x4 o; _Pragma("unroll") for (int x = 0; x < 4; ++x) o[x] = silu_f(cc[0][x]) * cc[1][x]; \
                        v2u w; w.x = pk2(o[0], o[1]); w.y = pk2(o[2], o[3]); *(v2u*)(Gb + (size_t)(pm * 256 + t) * DFF + f) = w; } } } } \
            asm volatile("s_waitcnt vmcnt(0)" ::: "memory"); __syncthreads(); \
        } \
        pg8::EpiResid<(LASTF) ? 2 : 1> E{nullptr, nullptr, out + O_Y, (bf16*)(ws + WS_XB), RSS_OUT}; \
        pg8::gemm_phase<pg8::EpiResid<(LASTF) ? 2 : 1>, pg8::StaticOrder>(lds, g, S, E); \
    }

#if REP_P4NULL
    {
        unsigned char* ws = KWS;
        pg8::Gemm g{(bf16*)(ws + WS_XB), (bf16*)(ws + WS_WUP0), T, UPW, DM}; pg8::StaticOrder S; S.init(T, UPW, G, bx);
        pg8::EpiNull E{(float*)(ws + WS_BIG + 100 * MiB)};
        pg8::gemm_phase<pg8::EpiNull, pg8::StaticOrder>(lds, g, S, E);
    }
#endif
    FFN_LAYER(0, rss, rss + T, false)
    GRID_BAR();

    for (int rep = 0; rep < REP_P7; ++rep) {
        unsigned char* ws = KWS;
        pg8::Gemm g{(bf16*)(ws + WS_XB), (bf16*)(ws + WS_WQKV), T, QKVW, DM}; pg8::StaticOrder S; S.init(T, QKVW, G, bx);
        pg8::EpiQKV E{(bf16*)(ws + WS_QO), (bf16*)(ws + WS_KN), (bf16*)(ws + WS_VT), (bf16*)(ws + WS_QKV), (float*)(ws + CTL_RSS) + T, KIN(13), KIN(14), (const f32x2*)(ws + WS_ROPE), KOUT};
        pg8::gemm_phase<pg8::EpiQKV, pg8::StaticOrder>(lds, g, S, E);
        { const int busy = ((T / 256) * (QKVW / 256)) % G; if (bx >= busy) { PHASE_IDS convert_group<false>(2, (bx - busy) * 8 + wave, (G - busy) * 8, lds, wave, lane); copy_old_cache(0, COPY_SPLIT, (bx - busy) * 512 + tid, (G - busy) * 512); } if (REP_P7 > 1) __syncthreads(); }
    }
    GRID_BAR();

    for (int rep = 0; rep < REP_P9; ++rep) {
        PHASE_IDS
        unsigned char* ws = KWS; const float* cache_k = KIN(2); const float* cache_v = KIN(3); const float* sinks = KIN(15);
        bf16* QKV = (bf16*)(ws + WS_QKV); bf16* QO = (bf16*)(ws + WS_QO); bf16* Kn = (bf16*)(ws + WS_KN); bf16* Vt = (bf16*)(ws + WS_VT);
        bf16* Oo = (rep < REP_P9 - 1) ? (bf16*)(ws + WS_BIG + 102 * MiB) : QO;
        {
            const bool xmap = (G == 256); const int xq = bx & 7, li = bx >> 3;
#define ATT_UNIT(k_) (xmap ? ((xq << 6) | (li + 32 * (k_))) : bx + (k_) * G)
            v4u kr[4], vr[4]; int uk = 0; int u = ATT_UNIT(0);
            if (u < 512) attn_unit_load(kr, vr, Kn, Vt, u >> 6, (u >> 4) & 3, u & 15, tid);
            for (; u < 512 && (!xmap || uk < 2); u = ATT_UNIT(uk)) {
                ++uk; const int unx = (xmap && uk >= 2) ? 512 : ATT_UNIT(uk);
                const int b = u >> 6, kvh = (u >> 4) & 3, qblk = u & 15;
                const int h = 4 * kvh + (wave >> 1); const float sl2 = sinks[h] * LOG2E;
                bf16x8 qa[4], qb[4];
                attn_q_load(qa, QO, b, h, qblk, 64 * (wave & 1), lane); attn_q_load(qb, QO, b, h, qblk, 64 * (wave & 1) + 32, lane);
                __syncthreads();
                attn_unit_store(lds, kr, vr, tid);
                __syncthreads();
                { const int un = (unx < 512) ? unx : u;
                  attn_unit_load(kr, vr, Kn, Vt, un >> 6, (un >> 4) & 3, un & 15, tid); }
                attn_sub_lds(lds, qa, Oo, sl2, b, h, qblk, 64 * (wave & 1), wave, lane);
                attn_sub_lds(lds, qb, Oo, sl2, b, h, qblk, 64 * (wave & 1) + 32, wave, lane);
            }
        }
        for (int sp0 = bx; sp0 < 256; sp0 += G) {
            const int sp = (G == 256) ? 32 * (bx & 7) + (bx >> 3) : sp0;
            const int b = sp >> 1, kvh0 = 2 * (sp & 1);
            bf16x8 qs[4]; float sl2s; attn_sample_q(qs, sl2s, QO, sinks, b, kvh0 + (wave & 1), lane);
            __syncthreads();
            attn_sample_stage2(lds, Kn, QKV, cache_k, cache_v, b, kvh0, tid);
            __syncthreads();
            if (wave < 2) attn_sample_lds(lds + wave * AS_UNIT, lds + AS_OOFF + wave * 4096, qs, sl2s, Oo, b, kvh0 + wave, lane);
        }
    }
    XCD_BAR();

    {
        unsigned char* ws = KWS; float* out = KOUT;
        pg8::Gemm g{(bf16*)(ws + WS_QO), (bf16*)(ws + WS_WO), NP, DM, DM}; pg8::StaticOrder S; S.init(NP, DM, G, bx);
        pg8::EpiResid<1> E{nullptr, nullptr, out + O_Y, (bf16*)(ws + WS_XB), (float*)(ws + CTL_RSS) + 2 * T};
        pg8::gemm_phase<pg8::EpiResid<1>, pg8::StaticOrder>(lds, g, S, E);
    }
    GRID_BAR();

    FFN_LAYER(1, rss + 2 * T, rss, true)
}

extern "C" void kernel_launch(void* const* d_in, const int* in_sizes, int n_in, void* d_out, int out_size, void* d_ws, size_t ws_size, hipStream_t stream) {
    static int grid = 0;
    if (grid == 0) {
        if (n_in != 22 || ws_size < WS_END) { fprintf(stderr, "kernel_launch: unexpected arguments (n_in %d, ws %zu)\n", n_in, ws_size); grid = -1; return; }
        int dev = 0, cus = 0;
        if (hipGetDevice(&dev) != hipSuccess || hipDeviceGetAttribute(&cus, hipDeviceAttributeMultiprocessorCount, dev) != hipSuccess) { grid = -1; return; }
        if (hipFuncSetAttribute((const void*)fwd_mega, hipFuncAttributeMaxDynamicSharedMemorySize, LDS_BYTES) != hipSuccess) { fprintf(stderr, "kernel_launch: hipFuncSetAttribute failed\n"); grid = -1; return; }
        int per_cu = 0;
        if (hipOccupancyMaxActiveBlocksPerMultiprocessor(&per_cu, (const void*)fwd_mega, 512, LDS_BYTES) != hipSuccess || per_cu < 1) fprintf(stderr, "kernel_launch: occupancy query reports %d blocks per CU\n", per_cu);
        (void)hipGetLastError();
        grid = cus & ~7;
        if (grid < 8) { grid = -1; return; }
    }
    if (grid < 0) return;
    (void)hipMemsetAsync((char*)d_ws + WS_CTL, 0, CTL_ZERO_BYTES, stream);
    Args a{};
    for (int i = 0; i < 22; ++i) a.in[i] = (const float*)d_in[i];
    a.out = (float*)d_out; a.ws = (unsigned char*)d_ws;
    hipLaunchKernelGGL(fwd_mega, dim3(grid), dim3(512), LDS_BYTES, stream, a);
}
```

```cpp
#include <hip/hip_runtime.h>
#include <cstdio>
#include <cstdint>

#define REP_P0 1
#define REP_P2 1
#define REP_P8 1
#define REP_P9 1
#define REP_P4 1
#define REP_P4NULL 0
#define REP_P1 1
#define REP_P3 1
#define REP_P7 1
#define PROBE_P3NULL 0
constexpr int DM = 1024, NP = 16384, NS = 1024, T = NP + NS;
constexpr int SEQ = 2048, NBP = 8, NBS = 128, DSEQ = 8, PAST = 8192;
constexpr int SW = 2048, DFF = 2816, UPW = 5632, QKVW = 1536, NH = 16, NKV = 4, HD = 64;
constexpr float EPS = 1e-6f;
constexpr float QSCALE = 0.125f * 1.4426950408889634f;
constexpr float LOG2E = 1.4426950408889634f;

constexpr size_t O_Y = 0, O_SGUV = 17825792, O_CKP = 19922944, O_CVP = 20185088, O_CKS = 20447232, O_CVS = 24641536, O_STP = 28835840, O_STS = 29016064;

constexpr size_t MiB = 1u << 20;
constexpr size_t WS_CTL = 0, CTL_ZERO_BYTES = 1 * MiB;
constexpr size_t WS_HB = 1 * MiB;
constexpr size_t WS_WSB = 7 * MiB;
constexpr size_t WS_ROPE = 7 * MiB + 256 * 1024;
constexpr size_t WS_WIN = 8 * MiB, WS_WOUT = 16 * MiB, WS_WUP0 = 20 * MiB, WS_WUP1 = 31 * MiB, WS_WDN0 = 42 * MiB, WS_WDN1 = 47 * MiB + 512 * 1024;
constexpr size_t WS_WQKV = 53 * MiB, WS_WO = 56 * MiB;
constexpr size_t WS_XB = 58 * MiB;
constexpr size_t WS_BIG = 92 * MiB;
constexpr size_t WS_U = WS_BIG, WS_V = WS_BIG + 68 * MiB;
constexpr size_t WS_G = WS_BIG;
constexpr size_t WS_QKV = WS_BIG, WS_QO = WS_BIG + 51 * MiB, WS_KN = WS_BIG + 85 * MiB, WS_VT = WS_BIG + 94 * MiB;
constexpr size_t WS_END = 256 * MiB;
constexpr int CW_BAR = 4096;
constexpr size_t CTL_LNS = 256 * 1024;
constexpr size_t CTL_RSS = 512 * 1024;

constexpr int RING_BYTES = 131072, XS_OFF = RING_BYTES, XS_BYTES = 8192, XP_OFF = XS_OFF + XS_BYTES, XP_BYTES = 5120, LDSCTL_OFF = XP_OFF + XP_BYTES, MISC_OFF = LDSCTL_OFF + 320, LDS_BYTES = 147456;
static_assert(MISC_OFF + 128 <= LDS_BYTES, "LDS map");

#define GAS __attribute__((address_space(1)))
#define LAS __attribute__((address_space(3)))
typedef unsigned short bf16;
typedef unsigned v4u __attribute__((ext_vector_type(4)));
typedef unsigned v2u __attribute__((ext_vector_type(2)));
typedef float f32x4 __attribute__((ext_vector_type(4)));
typedef float f32x2 __attribute__((ext_vector_type(2)));
typedef float f32x16 __attribute__((ext_vector_type(16)));
typedef short bf16x8 __attribute__((ext_vector_type(8)));
typedef GAS unsigned gu32;

typedef __bf16 bf16x2_hw __attribute__((ext_vector_type(2)));
__device__ __forceinline__ unsigned pk2(float lo, float hi) { const f32x2 v = {lo, hi}; return __builtin_bit_cast(unsigned, __builtin_convertvector(v, bf16x2_hw)); }
__device__ __forceinline__ unsigned f2bf(float f) { return pk2(f, 0.f) & 0xffffu; }
__device__ __forceinline__ float bflo(unsigned w) { return __uint_as_float(w << 16); }
__device__ __forceinline__ float bfhi(unsigned w) { return __uint_as_float(w & 0xffff0000u); }
__device__ __forceinline__ float bf1(bf16 x) { return __uint_as_float((unsigned)x << 16); }
__device__ __forceinline__ unsigned cvt_pk_bf16(float lo, float hi) { unsigned r; asm volatile("v_cvt_pk_bf16_f32 %0, %1, %2" : "=v"(r) : "v"(lo), "v"(hi)); return r; }
__device__ __forceinline__ float gelu_tanh(float x) {
    const float u = x * (0.7978845608f + 0.0356774081f * x * x);
    const float e = __builtin_amdgcn_exp2f(-2.885390082f * u);
    return x * __builtin_amdgcn_rcpf(1.0f + e);
}
__device__ __forceinline__ f32x2 gelu_tanh2(f32x2 x) {
    const f32x2 x2 = x * x; const f32x2 a = x * (x2 * (-0.10294323948f) + (-2.3022081983f));
    f32x2 e; e.x = __builtin_amdgcn_exp2f(a.x); e.y = __builtin_amdgcn_exp2f(a.y);
    const f32x2 d = e + 1.0f; f32x2 r; r.x = __builtin_amdgcn_rcpf(d.x); r.y = __builtin_amdgcn_rcpf(d.y);
    return x * r;
}
__device__ __forceinline__ f32x2 silu_mul2(f32x2 g, f32x2 v) {
    const f32x2 a = g * (-LOG2E); f32x2 e; e.x = __builtin_amdgcn_exp2f(a.x); e.y = __builtin_amdgcn_exp2f(a.y);
    const f32x2 d = e + 1.0f; f32x2 r; r.x = __builtin_amdgcn_rcpf(d.x); r.y = __builtin_amdgcn_rcpf(d.y);
    return (g * r) * v;
}
__device__ __forceinline__ float silu_f(float x) { return x * __builtin_amdgcn_rcpf(1.0f + __builtin_amdgcn_exp2f(-LOG2E * x)); }
__device__ __forceinline__ float dpp_shr1(float oldv, float src) {
    return __builtin_bit_cast(float, __builtin_amdgcn_update_dpp(__builtin_bit_cast(int, oldv), __builtin_bit_cast(int, src), 0x111, 0xf, 0xf, false));
}

__device__ __forceinline__ int tid_fresh() { int t = threadIdx.x; asm volatile("" : "+v"(t)); return t; }
namespace pg8 {
#define PG8_LAS __attribute__((address_space(3)))
typedef unsigned short bf16_t;
typedef unsigned u32x4 __attribute__((ext_vector_type(4)));
constexpr int BM = 256, BK = 64, HALF = 128, HTB = HALF * BK * 2, STAGE_BYTES = 8 * HTB, NXCD = 8, WGM = 8;

__host__ __device__ __forceinline__ int lds_byte(int r, int c) { const int st = (r >> 4) * 2 + (c >> 5), rr = r & 15, cc = c & 31, ob = rr * 64 + cc * 2; return st * 1024 + (ob ^ (((ob >> 9) & 1) << 5)); }
__host__ __device__ __forceinline__ void stage_rc(int b, int& R, int& C) { const int st = b / 1024, sb = b % 1024, swz = sb ^ (((sb >> 9) & 1) << 5); R = (st >> 1) * 16 + swz / 64; C = (st & 1) * 32 + (swz % 64) / 2; }
__host__ __device__ __forceinline__ int perm32(int rho) { const int n = rho >> 4, i = rho & 15; return 8 * (i >> 2) + 4 * n + (i & 3); }

struct Unit { int pm, pn; };
struct Gemm { const bf16_t* A; const bf16_t* Bt; int M, N, K; };

struct StaticOrder {
    int nM, nN, nwg, G, c;
    __host__ __device__ __forceinline__ void init(int M, int N, int G_, int c_) { nM = M / BM; nN = N / BM; nwg = nM * nN; G = G_; c = c_; }
    __host__ __device__ __forceinline__ bool next(int i, Unit& u) const {
        const long L = (long)i * G + c; if (L >= nwg) return false;
        int wgid = (int)L; { const int q = nwg / NXCD, r = nwg % NXCD, xcd = wgid % NXCD, off = wgid / NXCD; wgid = (xcd < r ? xcd * (q + 1) : r * (q + 1) + (xcd - r) * q) + off; }
        const int nig = WGM * nN, gid = wgid / nig, fm = gid * WGM, gsz = (nM - fm) < WGM ? (nM - fm) : WGM;
        u.pm = fm + ((wgid % nig) % gsz); u.pn = (wgid % nig) / gsz; return true;
    }
    __device__ __forceinline__ void a_ready(const Unit&) const {}
    __device__ __forceinline__ void done(const Unit&) const {}
};

struct BalOrder {
    StaticOrder so; bool xmap; int x, li, nN, per;
    __device__ __forceinline__ void init(int M, int N, int G_, int c_) { so.init(M, N, G_, c_); xmap = (G_ == 256) && (M == T); x = c_ & 7; li = c_ >> 3; nN = N / BM; per = 8 * nN + nN / 2; }
    __device__ __forceinline__ bool next(int i, Unit& u) const {
        if (!xmap) return so.next(i, u);
        const int j = i * 32 + li; if (j >= per) return false;
        const int ns = nN / 2, rounds = (per + 31) / 32, lb = per - 32 * (rounds - 1), nsh = 32 - lb;
        const int q = i * nsh + (li - lb);
        if (li >= lb && q < ns) { const int s = ns * x + q; u.pm = NP / BM + s / nN; u.pn = s % nN; return true; }
        const int b0 = (i * nsh < ns) ? i * nsh : ns, rem = ns - b0, d = li - lb;
        const int before = b0 + ((d > 0 && rem > 0) ? (d < rem ? d : rem) : 0);
        const int p = j - before; u.pm = 8 * x + (p & 7); u.pn = p >> 3;
        return true;
    }
    __device__ __forceinline__ bool idle(int bx_, int G_, int& idx, int& nidle) const {
        if (!xmap) { const int busy = so.nwg % G_; idx = bx_ - busy; nidle = G_ - busy; return bx_ >= busy; }
        const int rounds = (per + 31) / 32, lb = per - 32 * (rounds - 1);
        idx = x * (32 - lb) + (li - lb); nidle = 8 * (32 - lb); return li >= lb;
    }
    __device__ __forceinline__ void a_ready(const Unit&) const {}
    __device__ __forceinline__ void done(const Unit&) const {}
};


struct EpiGelu {
    static constexpr bool FUSEX = false;
    static constexpr bool WCOL = true, PDMA = true, PERM = true, PERMA = false, RIDE = true;
    bf16_t* U; bf16_t* V; float* lnS; const float* rss0; PG8_LAS unsigned char* xp;
    __device__ __forceinline__ void pdma(PG8_LAS unsigned char* xp_, const Unit& u, int wid, int lane_) const {
        const int lane = tid_fresh() & 63; (void)lane_;
        if (wid == 4) __builtin_amdgcn_global_load_lds((const unsigned*)(rss0 + u.pm * BM + lane * 4), (PG8_LAS unsigned*)(xp_ + 4096), 16, 0, 0);
        else if (wid == 5) __builtin_amdgcn_global_load_lds((const unsigned*)(rss0 + NP + 16 * u.pm + lane * 4), (PG8_LAS unsigned*)(xp_), 16, 0, 0);
    }
    __device__ __forceinline__ void operator()(f32x4 (&acc)[2][2][4][2], const Unit& u, int wr, int wc, int fr, int fq) const {
        const bool isv = u.pn >= 8; bf16_t* base = isv ? V : U;
        const int colt = (u.pn & 7) * BM + wc * 64 + 8 * fq, row0 = u.pm * BM + wr * 64 + fr;
#pragma unroll
        for (int ai = 0; ai < 2; ++ai)
#pragma unroll
            for (int m = 0; m < 4; ++m) { const int row = row0 + ai * HALF + m * 16; bf16_t* rowp = base + (size_t)row * SW + colt; float s = 0.f, q = 0.f;
                const float rs = __builtin_amdgcn_rsqf(*(const PG8_LAS float*)(xp + 4096 + (row - u.pm * BM) * 4) * (1.0f / DM) + EPS);
#pragma unroll
                for (int bj = 0; bj < 2; ++bj) { f32x4 v0 = acc[ai][bj][m][0] * rs, v1 = acc[ai][bj][m][1] * rs;
                    { const f32x2 a = gelu_tanh2((f32x2){v0[0], v0[1]}), b = gelu_tanh2((f32x2){v0[2], v0[3]}), c = gelu_tanh2((f32x2){v1[0], v1[1]}), d = gelu_tanh2((f32x2){v1[2], v1[3]});
                      v0 = (f32x4){a.x, a.y, b.x, b.y}; v1 = (f32x4){c.x, c.y, d.x, d.y}; }
                    if (isv) {
#pragma unroll
                        for (int x = 0; x < 4; ++x) { s += v0[x] + v1[x]; q += v0[x] * v0[x] + v1[x] * v1[x]; } }
                    u32x4 w; w.x = cvt_pk_bf16(v0[0], v0[1]); w.y = cvt_pk_bf16(v0[2], v0[3]); w.z = cvt_pk_bf16(v1[0], v1[1]); w.w = cvt_pk_bf16(v1[2], v1[3]);
                    *(u32x4*)(rowp + (bj ^ wr) * 32) = w; }
                if (isv) { s += __shfl_xor(s, 16); s += __shfl_xor(s, 32); q += __shfl_xor(q, 16); q += __shfl_xor(q, 32);
                    if (fq == 0) { atomicAdd(lnS + 2 * row, s); atomicAdd(lnS + 2 * row + 1, q); } } }
    }
    __device__ __forceinline__ void extra(const f32x4 (&ax)[2], const Unit& u, int wr, int wc, int fr, int fq) const {
        const bool isv = u.pn >= 8; bf16_t* base = isv ? V : U; const int row = NP + 16 * u.pm + fr;
        const float rsx = __builtin_amdgcn_rsqf(*(const PG8_LAS float*)(xp + fr * 4) * (1.0f / DM) + EPS);
        f32x4 v0 = ax[0] * rsx, v1 = ax[1] * rsx;
        { const f32x2 a = gelu_tanh2((f32x2){v0[0], v0[1]}), b = gelu_tanh2((f32x2){v0[2], v0[3]}), c = gelu_tanh2((f32x2){v1[0], v1[1]}), d = gelu_tanh2((f32x2){v1[2], v1[3]});
          v0 = (f32x4){a.x, a.y, b.x, b.y}; v1 = (f32x4){c.x, c.y, d.x, d.y}; }
        u32x4 w; w.x = cvt_pk_bf16(v0[0], v0[1]); w.y = cvt_pk_bf16(v0[2], v0[3]); w.z = cvt_pk_bf16(v1[0], v1[1]); w.w = cvt_pk_bf16(v1[2], v1[3]);
        *(u32x4*)(base + (size_t)row * SW + (u.pn & 7) * BM + wc * 64 + wr * 32 + 8 * fq) = w;
        if (isv) { float s = 0.f, q = 0.f;
#pragma unroll
            for (int x = 0; x < 4; ++x) { s += v0[x] + v1[x]; q += v0[x] * v0[x] + v1[x] * v1[x]; }
            s += __shfl_xor(s, 16); s += __shfl_xor(s, 32); q += __shfl_xor(q, 16); q += __shfl_xor(q, 32);
            if (fq == 0) { atomicAdd(lnS + 2 * row, s); atomicAdd(lnS + 2 * row + 1, q); } }
    }
};

template <int MODE> struct EpiResid {
    static constexpr bool WCOL = true, PDMA = false, PERM = true, PERMA = false, RIDE = true;
    const float* base_p; const float* base_s; float* out; bf16_t* XB; float* rss;
    __device__ __forceinline__ void row8(const f32x4& a0, const f32x4& a1, size_t off, bool samp, float& ss) const {
        f32x4 b0, b1;
        if (MODE == 0) { const float* bb = samp ? (base_s - (size_t)NP * DM) : base_p; b0 = *(const f32x4*)(bb + off); b1 = *(const f32x4*)(bb + off + 4); }
        else { const u32x4 r = *(const u32x4*)(XB + off); b0 = (f32x4){bflo(r.x), bfhi(r.x), bflo(r.y), bfhi(r.y)}; b1 = (f32x4){bflo(r.z), bfhi(r.z), bflo(r.w), bfhi(r.w)}; }
        const f32x4 o0 = b0 + a0, o1 = b1 + a1;
        if (MODE == 2) { *(f32x4*)(out + off) = o0; *(f32x4*)(out + off + 4) = o1; }
        else {
#pragma unroll
            for (int x = 0; x < 4; ++x) ss += o0[x] * o0[x] + o1[x] * o1[x];
            u32x4 w; w.x = cvt_pk_bf16(o0[0], o0[1]); w.y = cvt_pk_bf16(o0[2], o0[3]); w.z = cvt_pk_bf16(o1[0], o1[1]); w.w = cvt_pk_bf16(o1[2], o1[3]);
            *(u32x4*)(XB + off) = w; }
    }
    __device__ __forceinline__ void fin8(const f32x4& b0, const f32x4& b1, const f32x4& a0, const f32x4& a1, size_t off, float& ss) const {
        const f32x4 o0 = b0 + a0, o1 = b1 + a1;
        if (MODE == 2) { *(f32x4*)(out + off) = o0; *(f32x4*)(out + off + 4) = o1; }
        else {
#pragma unroll
            for (int x = 0; x < 4; ++x) ss += o0[x] * o0[x] + o1[x] * o1[x];
            u32x4 w; w.x = cvt_pk_bf16(o0[0], o0[1]); w.y = cvt_pk_bf16(o0[2], o0[3]); w.z = cvt_pk_bf16(o1[0], o1[1]); w.w = cvt_pk_bf16(o1[2], o1[3]);
            *(u32x4*)(XB + off) = w; }
    }
    static constexpr bool FUSEX = true;
    __device__ __forceinline__ void fused(f32x4 (&acc)[2][2][4][2], const f32x4 (&ax)[2], const Unit& u, int wr, int wc, int fr, int fq) const {
        const int row0 = u.pm * BM + wr * 64 + fr, col0 = u.pn * BM + wc * 64 + 8 * fq; const bool samp = u.pm >= NP / BM;
        const int rowx = NP + 16 * u.pm + fr; const size_t offx = (size_t)rowx * DM + u.pn * BM + wc * 64 + wr * 32 + 8 * fq;
        f32x4 xb0, xb1; u32x4 xraw;
        if (MODE == 0) { const float* bx_ = base_s - (size_t)NP * DM; xb0 = *(const f32x4*)(bx_ + offx); xb1 = *(const f32x4*)(bx_ + offx + 4); }
        else xraw = *(const u32x4*)(XB + offx);
#define RES_X() do { float ssx = 0.f; if (MODE != 0) { xb0 = (f32x4){bflo(xraw.x), bfhi(xraw.x), bflo(xraw.y), bfhi(xraw.y)}; xb1 = (f32x4){bflo(xraw.z), bfhi(xraw.z), bflo(xraw.w), bfhi(xraw.w)}; } \
            fin8(xb0, xb1, ax[0], ax[1], offx, ssx); if (MODE != 2) { ssx += __shfl_xor(ssx, 16); ssx += __shfl_xor(ssx, 32); if (fq == 0) atomicAdd(rss + rowx, ssx); } } while (0)
        if (MODE == 0) {
            const float* bb = samp ? (base_s - (size_t)NP * DM) : base_p;
            f32x4 rb[2][2][2][2];
#define RES_LD0(q_) do { _Pragma("unroll") for (int mm = 0; mm < 2; ++mm) _Pragma("unroll") for (int bj = 0; bj < 2; ++bj) { \
                const size_t off_ = (size_t)(row0 + ((q_) >> 1) * HALF + (((q_) & 1) * 2 + mm) * 16) * DM + col0 + (bj ^ wr) * 32; rb[(q_) & 1][mm][bj][0] = *(const f32x4*)(bb + off_); rb[(q_) & 1][mm][bj][1] = *(const f32x4*)(bb + off_ + 4); } } while (0)
            RES_LD0(0);
            RES_X();
#pragma unroll
            for (int q = 0; q < 4; ++q) { if (q + 1 < 4) RES_LD0(q + 1);
#pragma unroll
                for (int mm = 0; mm < 2; ++mm) { const int ai = q >> 1, m = (q & 1) * 2 + mm, row = row0 + ai * HALF + m * 16; const size_t off = (size_t)row * DM + col0; float ss = 0.f;
#pragma unroll
                    for (int bj = 0; bj < 2; ++bj) fin8(rb[q & 1][mm][bj][0], rb[q & 1][mm][bj][1], acc[ai][bj][m][0], acc[ai][bj][m][1], off + (bj ^ wr) * 32, ss);
                    ss += __shfl_xor(ss, 16); ss += __shfl_xor(ss, 32); if (fq == 0) atomicAdd(rss + row, ss); } }
#undef RES_LD0
        } else {
            u32x4 rb[2][4][2];
#define RES_LD1(ai_, m_) do { _Pragma("unroll") for (int bj = 0; bj < 2; ++bj) rb[ai_][m_][bj] = *(const u32x4*)(XB + (size_t)(row0 + (ai_) * HALF + (m_) * 16) * DM + col0 + (bj ^ wr) * 32); } while (0)
#pragma unroll
            for (int q = 0; q < 6; ++q) RES_LD1(q >> 2, q & 3);
            RES_X();
#pragma unroll
            for (int ai = 0; ai < 2; ++ai)
#pragma unroll
                for (int m = 0; m < 4; ++m) { const int row = row0 + ai * HALF + m * 16; const size_t off = (size_t)row * DM + col0; float ss = 0.f;
                    if (ai == 0 && m == 1) RES_LD1(1, 2);
                    if (ai == 0 && m == 2) RES_LD1(1, 3);
#pragma unroll
                    for (int bj = 0; bj < 2; ++bj) { const u32x4 r = rb[ai][m][bj];
                        fin8((f32x4){bflo(r.x), bfhi(r.x), bflo(r.y), bfhi(r.y)}, (f32x4){bflo(r.z), bfhi(r.z), bflo(r.w), bfhi(r.w)}, acc[ai][bj][m][0], acc[ai][bj][m][1], off + (bj ^ wr) * 32, ss); }
                if (MODE != 2) { ss += __shfl_xor(ss, 16); ss += __shfl_xor(ss, 32); if (fq == 0) atomicAdd(rss + row, ss); } }
        }
#undef RES_X
#undef RES_LD1
    }
    __device__ __forceinline__ void extra(const f32x4 (&ax)[2], const Unit& u, int wr, int wc, int fr, int fq) const {
        const int row = NP + 16 * u.pm + fr; const size_t off = (size_t)row * DM + u.pn * BM + wc * 64 + wr * 32 + 8 * fq; float ss = 0.f;
        row8(ax[0], ax[1], off, true, ss);
        if (MODE != 2) { ss += __shfl_xor(ss, 16); ss += __shfl_xor(ss, 32); if (fq == 0) atomicAdd(rss + row, ss); }
    }
};

struct EpiQKV {
    static constexpr bool WCOL = false, PDMA = false, PERM = true, PERMA = true, RIDE = false;
    bf16_t* QO; bf16_t* Kn; bf16_t* Vt; bf16_t* Vs; const float* rss; const float* qn; const float* kn; const f32x2* rope; float* out;
    __device__ __forceinline__ void operator()(f32x4 (&acc)[2][2][4][2], const Unit& u, int wr, int wc, int fr, int fq) const {
        const bool samp = u.pm >= NP / BM;
        if (u.pn < 5) {
            const bool isk = u.pn == 4; const float* gn = isk ? kn : qn; const float osc = isk ? 1.0f : QSCALE;
            const f32x4 gl0 = *(const f32x4*)(gn + 8 * fq), gl1 = *(const f32x4*)(gn + 8 * fq + 4), gh0 = *(const f32x4*)(gn + 32 + 8 * fq), gh1 = *(const f32x4*)(gn + 32 + 8 * fq + 4);
            const f32x4* sp = (const f32x4*)(rope + 32 + 8 * fq); const f32x4 st0 = sp[0], st1 = sp[1], st2 = sp[2], st3 = sp[3];
            f32x4 tb[2][4], r4s[2];
#define QKV_TLOAD(ai_) do { const int row0_ = u.pm * BM + (ai_) * HALF + wr * 64 + 4 * fr; r4s[ai_] = *(const f32x4*)(rss + row0_); \
                const int pi0_ = samp ? SEQ + (row0_ & 7) : (row0_ & (SEQ - 1)); const f32x4* tp_ = (const f32x4*)(rope + pi0_ * 32 + 8 * fq); \
                tb[ai_][0] = tp_[0]; tb[ai_][1] = tp_[1]; tb[ai_][2] = tp_[2]; tb[ai_][3] = tp_[3]; } while (0)
            QKV_TLOAD(0);
#pragma unroll
            for (int ai = 0; ai < 2; ++ai) { const int row0 = u.pm * BM + ai * HALF + wr * 64 + 4 * fr; const f32x4 r4 = r4s[ai];
                f32x4 t0 = tb[ai][0], t1 = tb[ai][1], t2 = tb[ai][2], t3 = tb[ai][3];
#pragma unroll
                for (int m = 0; m < 4; ++m) { const int row = row0 + m; const float rs = __builtin_amdgcn_rsqf(r4[m] * (1.0f / DM) + EPS);
                    if (ai == 0 && m == 1) QKV_TLOAD(1);
                    if (m > 0) {
#define ROT_STEP(t_, s_) do { const f32x4 o_ = t_; t_[0] = o_[0] * s_[0] - o_[1] * s_[1]; t_[1] = o_[1] * s_[0] + o_[0] * s_[1]; t_[2] = o_[2] * s_[2] - o_[3] * s_[3]; t_[3] = o_[3] * s_[2] + o_[2] * s_[3]; } while (0)
                        ROT_STEP(t0, st0); ROT_STEP(t1, st1); ROT_STEP(t2, st2); ROT_STEP(t3, st3);
#undef ROT_STEP
                    }
                    f32x4 l0 = acc[ai][0][m][0] * rs, l1 = acc[ai][0][m][1] * rs, h0 = acc[ai][1][m][0] * rs, h1 = acc[ai][1][m][1] * rs;
                    float ss = 0.f;
#pragma unroll
                    for (int x = 0; x < 4; ++x) ss += l0[x] * l0[x] + l1[x] * l1[x] + h0[x] * h0[x] + h1[x] * h1[x];
                    ss += __shfl_xor(ss, 16); ss += __shfl_xor(ss, 32);
                    const float hr = __builtin_amdgcn_rsqf(ss * (1.0f / HD) + EPS);
                    l0 = l0 * hr * gl0; l1 = l1 * hr * gl1; h0 = h0 * hr * gh0; h1 = h1 * hr * gh1;
                    f32x4 ol0, ol1, oh0, oh1;
                    ol0[0] = l0[0] * t0[0] - h0[0] * t0[1]; oh0[0] = h0[0] * t0[0] + l0[0] * t0[1]; ol0[1] = l0[1] * t0[2] - h0[1] * t0[3]; oh0[1] = h0[1] * t0[2] + l0[1] * t0[3];
                    ol0[2] = l0[2] * t1[0] - h0[2] * t1[1]; oh0[2] = h0[2] * t1[0] + l0[2] * t1[1]; ol0[3] = l0[3] * t1[2] - h0[3] * t1[3]; oh0[3] = h0[3] * t1[2] + l0[3] * t1[3];
                    ol1[0] = l1[0] * t2[0] - h1[0] * t2[1]; oh1[0] = h1[0] * t2[0] + l1[0] * t2[1]; ol1[1] = l1[1] * t2[2] - h1[1] * t2[3]; oh1[1] = h1[1] * t2[2] + l1[1] * t2[3];
                    ol1[2] = l1[2] * t3[0] - h1[2] * t3[1]; oh1[2] = h1[2] * t3[0] + l1[2] * t3[1]; ol1[3] = l1[3] * t3[2] - h1[3] * t3[3]; oh1[3] = h1[3] * t3[2] + l1[3] * t3[3];
                    u32x4 wl, wh;
                    wl.x = cvt_pk_bf16(ol0[0] * osc, ol0[1] * osc); wl.y = cvt_pk_bf16(ol0[2] * osc, ol0[3] * osc); wl.z = cvt_pk_bf16(ol1[0] * osc, ol1[1] * osc); wl.w = cvt_pk_bf16(ol1[2] * osc, ol1[3] * osc);
                    wh.x = cvt_pk_bf16(oh0[0] * osc, oh0[1] * osc); wh.y = cvt_pk_bf16(oh0[2] * osc, oh0[3] * osc); wh.z = cvt_pk_bf16(oh1[0] * osc, oh1[1] * osc); wh.w = cvt_pk_bf16(oh1[2] * osc, oh1[3] * osc);
                    { bf16_t* d = isk ? Kn + (size_t)row * 256 + wc * HD + 8 * fq : QO + (size_t)row * DM + (4 * u.pn + wc) * HD + 8 * fq; *(u32x4*)d = wl; *(u32x4*)(d + 32) = wh; }
                    if (isk) {
                        float* co = nullptr;
                        if (samp) co = out + O_CKS + (((size_t)((row - NP) >> 3) * 128 + 120 + (row & 7)) * NKV + wc) * HD + 8 * fq;
                        else if ((row & (SEQ - 1)) >= SEQ - 128) co = out + O_CKP + (((size_t)(row >> 11) * 128 + ((row & (SEQ - 1)) - (SEQ - 128))) * NKV + wc) * HD + 8 * fq;
                        if (co) { *(f32x4*)co = ol0; *(f32x4*)(co + 4) = ol1; *(f32x4*)(co + 32) = oh0; *(f32x4*)(co + 36) = oh1; } }
                } }
        } else {
            f32x4 r4v[2];
#pragma unroll
            for (int ai = 0; ai < 2; ++ai) r4v[ai] = *(const f32x4*)(rss + u.pm * BM + ai * HALF + wr * 64 + 4 * fr);
#pragma unroll
            for (int ai = 0; ai < 2; ++ai) { const int row0 = u.pm * BM + ai * HALF + wr * 64 + 4 * fr; const f32x4 r4 = r4v[ai];
                f32x4 rs4;
#pragma unroll
                for (int m = 0; m < 4; ++m) rs4[m] = __builtin_amdgcn_rsqf(r4[m] * (1.0f / DM) + EPS);
#pragma unroll
                for (int bj = 0; bj < 2; ++bj) { const int kvh = 2 * bj + (wc >> 1), d0 = 32 * (wc & 1) + 8 * fq;
                    if (!samp) { bf16_t* vp = Vt + ((size_t)((u.pm >> 3) * NKV + kvh) * HD + d0) * SEQ + (row0 & (SEQ - 1));
#pragma unroll
                        for (int n = 0; n < 2; ++n)
#pragma unroll
                            for (int x = 0; x < 4; ++x) { v2u w; w.x = cvt_pk_bf16(acc[ai][bj][0][n][x] * rs4[0], acc[ai][bj][1][n][x] * rs4[1]); w.y = cvt_pk_bf16(acc[ai][bj][2][n][x] * rs4[2], acc[ai][bj][3][n][x] * rs4[3]);
                                *(v2u*)(vp + (size_t)(4 * n + x) * SEQ) = w; }
                        if ((u.pm & 7) == 7 && ai == 1) {
#pragma unroll
                            for (int m = 0; m < 4; ++m) { float* co = out + O_CVP + (((size_t)(u.pm >> 3) * 128 + ((row0 + m) & 127)) * NKV + kvh) * HD + d0;
                                *(f32x4*)co = acc[ai][bj][m][0] * rs4[m]; *(f32x4*)(co + 4) = acc[ai][bj][m][1] * rs4[m]; } }
                    } else {
#pragma unroll
                        for (int m = 0; m < 4; ++m) { const int row = row0 + m; const f32x4 v0 = acc[ai][bj][m][0] * rs4[m], v1 = acc[ai][bj][m][1] * rs4[m];
                            u32x4 w; w.x = cvt_pk_bf16(v0[0], v0[1]); w.y = cvt_pk_bf16(v0[2], v0[3]); w.z = cvt_pk_bf16(v1[0], v1[1]); w.w = cvt_pk_bf16(v1[2], v1[3]);
                            *(u32x4*)(Vs + (size_t)(row - NP) * 256 + kvh * HD + d0) = w;
                            float* co = out + O_CVS + (((size_t)((row - NP) >> 3) * 128 + 120 + (row & 7)) * NKV + kvh) * HD + d0; *(f32x4*)co = v0; *(f32x4*)(co + 4) = v1; } } } }
        }
    }
};

struct EpiNull {
    static constexpr bool WCOL = false, PDMA = false, PERM = true, PERMA = true, RIDE = false;
    float* D;
    __device__ __forceinline__ void operator()(f32x4 (&acc)[2][2][4][2], const Unit& u, int wr, int wc, int fr, int fq) const {
        f32x4 s = (f32x4){0.f, 0.f, 0.f, 0.f};
#pragma unroll
        for (int ai = 0; ai < 2; ++ai)
#pragma unroll
            for (int bj = 0; bj < 2; ++bj)
#pragma unroll
                for (int m = 0; m < 4; ++m) { s += acc[ai][bj][m][0]; s += acc[ai][bj][m][1]; }
        D[((size_t)(u.pm * 32 + u.pn) * 8 + wr * 4 + wc) * 64 + fq * 16 + fr] = s[0] + s[1] + s[2] + s[3];
    }
};

template <bool RIDE_> struct EpiNull2 {
    static constexpr bool WCOL = false, PDMA = false, PERM = true, PERMA = false, RIDE = RIDE_;
    float* D;
    __device__ __forceinline__ void operator()(f32x4 (&acc)[2][2][4][2], const Unit& u, int wr, int wc, int fr, int fq) const {
        f32x4 s = (f32x4){0.f, 0.f, 0.f, 0.f};
#pragma unroll
        for (int ai = 0; ai < 2; ++ai)
#pragma unroll
            for (int bj = 0; bj < 2; ++bj)
#pragma unroll
                for (int m = 0; m < 4; ++m) { s += acc[ai][bj][m][0]; s += acc[ai][bj][m][1]; }
        D[((size_t)(u.pm * 32 + u.pn) * 8 + wr * 4 + wc) * 64 + fq * 16 + fr] = s[0] + s[1] + s[2] + s[3];
    }
    __device__ __forceinline__ void extra(const f32x4 (&ax)[2], const Unit& u, int wr, int wc, int fr, int fq) const {
        const f32x4 s = ax[0] + ax[1];
        D[1048576 + ((size_t)(u.pm * 32 + u.pn) * 8 + wr * 4 + wc) * 64 + fq * 16 + fr] = s[0] + s[1] + s[2] + s[3];
    }
};
struct EpiUpConv {
    static constexpr bool WCOL = false, PDMA = true, PERM = true, PERMA = true, RIDE = false;
    bf16_t* G; const float* rss; const float* cw; const float* cb; const float* past; float* HB; float* st_p; float* st_s; PG8_LAS float* xs;
    __device__ __forceinline__ void pdma(PG8_LAS unsigned char* xp, const Unit& u, int wid, int lane) const {
        if (wid < 4) { const float* src = (wid < 3 ? cw + (size_t)wid * UPW : cb) + (lane >> 5) * DFF + u.pn * HALF + (lane & 31) * 4;
            __builtin_amdgcn_global_load_lds((const unsigned*)src, (PG8_LAS unsigned*)(xp + wid * 1024), 16, 0, 0); }
        else if (wid == 4) { __builtin_amdgcn_global_load_lds((const unsigned*)(rss + u.pm * BM + lane * 4), (PG8_LAS unsigned*)(xp + 4096), 16, 0, 0); }
    }
    PG8_LAS unsigned char* xp;
    __device__ __forceinline__ void operator()(f32x4 (&acc)[2][2][4][2], const Unit& u, int wr, int wc, int fr, int fq) const {
        const bool samp = u.pm >= NP / BM;
        const int f0 = u.pn * HALF + wc * 32 + 8 * fq;
        f32x4 r4s[2];
#pragma unroll
        for (int ai = 0; ai < 2; ++ai) r4s[ai] = *(const PG8_LAS f32x4*)(xp + 4096 + (ai * HALF + wr * 64 + 4 * fr) * 4);
#pragma unroll
        for (int ai = 0; ai < 2; ++ai) { const f32x4 r4 = r4s[ai];
#pragma unroll
            for (int m = 0; m < 4; ++m) { const float rs = __builtin_amdgcn_rsqf(r4[m] * (1.0f / DM) + EPS);
#pragma unroll
                for (int bj = 0; bj < 2; ++bj) { acc[ai][bj][m][0] = acc[ai][bj][m][0] * rs; acc[ai][bj][m][1] = acc[ai][bj][m][1] * rs; } } }
        if (fr == 15) {
#pragma unroll
            for (int ai = 0; ai < 2; ++ai) { const int s = 2 * ai + wr;
#pragma unroll
                for (int bj = 0; bj < 2; ++bj)
#pragma unroll
                    for (int mm = 0; mm < 2; ++mm)
#pragma unroll
                        for (int n = 0; n < 2; ++n) *(PG8_LAS f32x4*)(xs + 4 * ((((((s * 4 + wc) * 4 + fq) * 2 + bj) * 2 + mm) * 2) + n)) = acc[ai][bj][2 + mm][n]; } }
        if (!samp) {
            if (wr == 0 && fr == 0) {
#pragma unroll
                for (int bj = 0; bj < 2; ++bj)
#pragma unroll
                    for (int mm = 0; mm < 2; ++mm)
#pragma unroll
                        for (int n = 0; n < 2; ++n) *(f32x4*)(HB + ((size_t)u.pm * 4 + mm) * UPW + bj * DFF + f0 + 4 * n) = acc[0][bj][mm][n]; }
            if (wr == 1 && fr == 15) {
#pragma unroll
                for (int bj = 0; bj < 2; ++bj)
#pragma unroll
                    for (int mm = 0; mm < 2; ++mm)
#pragma unroll
                        for (int n = 0; n < 2; ++n) { const f32x4 v = acc[1][bj][2 + mm][n]; *(f32x4*)(HB + ((size_t)u.pm * 4 + 2 + mm) * UPW + bj * DFF + f0 + 4 * n) = v;
                            if ((u.pm & 7) == 7) *(f32x4*)(st_p + ((size_t)(u.pm >> 3) * 2 + mm) * UPW + bj * DFF + f0 + 4 * n) = v; } }
        } else if (fr & 1) {
#pragma unroll
            for (int ai = 0; ai < 2; ++ai) { const int b = 32 * (u.pm - NP / BM) + 8 * (2 * ai + wr) + (fr >> 1);
#pragma unroll
                for (int bj = 0; bj < 2; ++bj)
#pragma unroll
                    for (int mm = 0; mm < 2; ++mm)
#pragma unroll
                        for (int n = 0; n < 2; ++n) *(f32x4*)(st_s + ((size_t)b * 2 + mm) * UPW + bj * DFF + f0 + 4 * n) = acc[ai][bj][2 + mm][n]; } }
        asm volatile("s_waitcnt lgkmcnt(0)" ::: "memory"); __builtin_amdgcn_s_barrier(); asm volatile("" ::: "memory");
        v2u olo[2][4];
#pragma unroll
        for (int n = 0; n < 2; ++n) {
            f32x4 w0[2], w1[2], w2[2], bb[2];
#pragma unroll
            for (int bj = 0; bj < 2; ++bj) { const int o = bj * 512 + (wc * 32 + 8 * fq + 4 * n) * 4; w0[bj] = *(const PG8_LAS f32x4*)(xp + o); w1[bj] = *(const PG8_LAS f32x4*)(xp + 1024 + o); w2[bj] = *(const PG8_LAS f32x4*)(xp + 2048 + o); bb[bj] = *(const PG8_LAS f32x4*)(xp + 3072 + o); }
            f32x4 sp2[2][2], sp3[2][2];
            if (samp) {
#pragma unroll
                for (int ai = 0; ai < 2; ++ai)
#pragma unroll
                    for (int bj = 0; bj < 2; ++bj) { const int b = 32 * (u.pm - NP / BM) + 8 * (2 * ai + wr) + (fr >> 1);
                        sp2[ai][bj] = *(const f32x4*)(past + ((size_t)b * 2 + 0) * UPW + bj * DFF + f0 + 4 * n); sp3[ai][bj] = *(const f32x4*)(past + ((size_t)b * 2 + 1) * UPW + bj * DFF + f0 + 4 * n); } }
#pragma unroll
            for (int ai = 0; ai < 2; ++ai) { const int s = 2 * ai + wr;
                f32x4 cc[2][4];
#pragma unroll
                for (int bj = 0; bj < 2; ++bj) {
                    f32x4 B2, B3;
                    if (s == 0) { B2 = (f32x4){0.f, 0.f, 0.f, 0.f}; B3 = B2; }
                    else { const int sp = s - 1; B2 = *(PG8_LAS f32x4*)(xs + 4 * ((((((sp * 4 + wc) * 4 + fq) * 2 + bj) * 2 + 0) * 2) + n)); B3 = *(PG8_LAS f32x4*)(xs + 4 * ((((((sp * 4 + wc) * 4 + fq) * 2 + bj) * 2 + 1) * 2) + n)); }
                    const f32x4 v0 = acc[ai][bj][0][n], v1 = acc[ai][bj][1][n], v2 = acc[ai][bj][2][n], v3 = acc[ai][bj][3][n];
                    f32x4 P2, P3;
#pragma unroll
                    for (int x = 0; x < 4; ++x) { P2[x] = dpp_shr1(B2[x], v2[x]); P3[x] = dpp_shr1(B3[x], v3[x]); }
                    cc[bj][0] = bb[bj] + w2[bj] * v0 + w1[bj] * P3 + w0[bj] * P2;
                    cc[bj][1] = bb[bj] + w2[bj] * v1 + w1[bj] * v0 + w0[bj] * P3;
                    if (samp) { const f32x4 S2 = sp2[ai][bj], S3 = sp3[ai][bj];
                        if (!(fr & 1)) { cc[bj][0] = bb[bj] + w2[bj] * v0 + w1[bj] * S3 + w0[bj] * S2; cc[bj][1] = bb[bj] + w2[bj] * v1 + w1[bj] * v0 + w0[bj] * S3; } }
                    cc[bj][2] = bb[bj] + w2[bj] * v2 + w1[bj] * v1 + w0[bj] * v0;
                    cc[bj][3] = bb[bj] + w2[bj] * v3 + w1[bj] * v2 + w0[bj] * v1; }
#pragma unroll
                for (int m = 0; m < 4; ++m) { const int row = u.pm * BM + ai * HALF + wr * 64 + 4 * fr + m;
                    const f32x2 oa = silu_mul2((f32x2){cc[0][m][0], cc[0][m][1]}, (f32x2){cc[1][m][0], cc[1][m][1]}), ob = silu_mul2((f32x2){cc[0][m][2], cc[0][m][3]}, (f32x2){cc[1][m][2], cc[1][m][3]});
                    if (n == 0) { olo[ai][m].x = cvt_pk_bf16(oa.x, oa.y); olo[ai][m].y = cvt_pk_bf16(ob.x, ob.y); }
                    else { u32x4 w; w.x = olo[ai][m].x; w.y = olo[ai][m].y; w.z = cvt_pk_bf16(oa.x, oa.y); w.w = cvt_pk_bf16(ob.x, ob.y); *(u32x4*)(G + (size_t)row * DFF + f0) = w; } } } }
    }
};

template <class Epi, class Sched, bool ALIGN_EPI = true>
__device__ __forceinline__ void gemm_phase(PG8_LAS unsigned char* lds, const Gemm g, const Sched& S, const Epi& E) {
    const int tid = tid_fresh(), wid = __builtin_amdgcn_readfirstlane(tid >> 6), lane = tid & 63, wr = wid >> 2, wc = wid & 3, fr = lane & 15, fq = lane >> 4;
    const int K = g.K, nt = K / BK;
    unsigned voffA[2], voffB[2];
#pragma unroll
    for (int i = 0; i < 2; ++i) { int R, C; stage_rc(tid * 16 + i * 8192, R, C); const int Rb = Epi::WCOL ? (64 * (R >> 5) + perm32(R & 31)) : (Epi::PERM ? ((R & ~31) + perm32(R & 31)) : R);
        const int Ra = Epi::PERMA ? ((R & 64) + 4 * (R & 15) + ((R >> 4) & 3)) : R;
        voffA[i] = (unsigned)(Ra * K + C) * 2u; voffB[i] = (unsigned)(Rb * K + C) * 2u; }
    const size_t kstep = (size_t)(BK * 2);
    const size_t hstep = (size_t)HALF * K * 2;
    const size_t tstep = 2 * hstep;
    const size_t bhstep = Epi::WCOL ? (size_t)32 * K * 2 : hstep;
    const unsigned ldsw = (unsigned)wid * 1024u;
    const int aoff = lds_byte(wr * 64 + fr, fq * 8), boff = lds_byte(wc * 32 + fr, fq * 8);
    const int bsw = Epi::RIDE ? wr : 0;
#define PG8_SA(b, h) (((b) * 2 + (h)) * HTB)
#define PG8_SB(b, h) ((4 + (b) * 2 + (h)) * HTB)
    const __amdgpu_buffer_rsrc_t rsA = __builtin_amdgcn_make_buffer_rsrc((void*)g.A, 0, 0x7ffffff0, 0x00020000), rsB = __builtin_amdgcn_make_buffer_rsrc((void*)g.Bt, 0, 0x7ffffff0, 0x00020000);
#define PG8_STAGE(bufoff, gbase, voff) do { const bool isA_ = ((const void*)(voff) == (const void*)voffA); \
        const unsigned so_ = (unsigned)((const char*)(gbase) - (isA_ ? (const char*)g.A : (const char*)g.Bt)); \
        _Pragma("unroll") for (int _i = 0; _i < 2; ++_i) { \
            if (isA_) __builtin_amdgcn_raw_ptr_buffer_load_lds(rsA, (PG8_LAS void*)(lds + (bufoff) + ldsw + _i * 8192), 16, (voff)[_i], so_, 0, 0); \
            else      __builtin_amdgcn_raw_ptr_buffer_load_lds(rsB, (PG8_LAS void*)(lds + (bufoff) + ldsw + _i * 8192), 16, (voff)[_i], so_, 0, 0); } } while (0)
#define PG8_LDA(dst, b, h) do { _Pragma("unroll") for (int m = 0; m < 4; ++m) _Pragma("unroll") for (int k = 0; k < 2; ++k) dst[m][k] = *(const PG8_LAS bf16x8*)(lds + PG8_SA(b, h) + aoff + m * 2048 + k * 1024); } while (0)
#define PG8_LDB(dst, b, h) do { _Pragma("unroll") for (int n = 0; n < 2; ++n) _Pragma("unroll") for (int k = 0; k < 2; ++k) dst[n][k] = *(const PG8_LAS bf16x8*)(lds + PG8_SB(b, 0) + ((h) ^ bsw) * HTB + boff + n * 2048 + k * 1024); } while (0)
#define PG8_MMA(ai, bj, At, Bt) do { __builtin_amdgcn_s_setprio(1); _Pragma("unroll") for (int m = 0; m < 4; ++m) _Pragma("unroll") for (int n = 0; n < 2; ++n) _Pragma("unroll") for (int k = 0; k < 2; ++k) \
        acc[ai][bj][m][n] = __builtin_amdgcn_mfma_f32_16x16x32_bf16(Bt[n][k], At[m][k], acc[ai][bj][m][n], 0, 0, 0); __builtin_amdgcn_s_setprio(0); } while (0)
#define PG8_WAIT_V(n) asm volatile("s_waitcnt vmcnt(" #n ")" ::: "memory")
#define PG8_WAIT_L(n) asm volatile("s_waitcnt lgkmcnt(" #n ")" ::: "memory")
#define PG8_BAR __builtin_amdgcn_s_barrier()
#define PG8_SCHED __builtin_amdgcn_sched_barrier(0)
    Unit cur, nxt; int ui = 0;
    if (!S.next(0, cur)) return;
    f32x4 acc[2][2][4][2];
#pragma unroll
    for (int a = 0; a < 2; ++a)
#pragma unroll
        for (int b = 0; b < 2; ++b)
#pragma unroll
            for (int m = 0; m < 4; ++m)
#pragma unroll
                for (int n = 0; n < 2; ++n) acc[a][b][m][n] = (f32x4){0.f, 0.f, 0.f, 0.f};
    bf16x8 At[4][2], B0[2][2], B1[2][2];
    const char* cA = (const char*)g.A + (size_t)cur.pm * tstep; const char* cB = (const char*)g.Bt + (size_t)cur.pn * tstep;
    f32x4 accx[2]; bf16x8 axf[2]; const unsigned xlane = (unsigned)(fr * K + 8 * fq) * 2u; unsigned xrow = 0;
    const unsigned xvoff = xlane + (unsigned)wid * 64u;
#define PG8_XDMA(tile, xr) do { if (wid < 2) { \
        __builtin_amdgcn_raw_ptr_buffer_load_lds(rsA, (PG8_LAS void*)(lds + XS_OFF + ((tile) & 3) * 2048 + wid * 1024), 16, xvoff, (unsigned)(xr) + (unsigned)(tile) * 128u, 0, 0); } } while (0)
    if constexpr (Epi::RIDE) { accx[0] = (f32x4){0.f, 0.f, 0.f, 0.f}; accx[1] = accx[0];
        xrow = (unsigned)(NP + 16 * cur.pm) * (unsigned)K * 2u; PG8_XDMA(0, xrow); PG8_XDMA(1, xrow); }
#define PG8_XMMA(Bs) do { _Pragma("unroll") for (int k = 0; k < 2; ++k) _Pragma("unroll") for (int n = 0; n < 2; ++n) accx[n] = __builtin_amdgcn_mfma_f32_16x16x32_bf16(Bs[n][k], axf[k], accx[n], 0, 0, 0); } while (0)
#define PG8_RIDE_LD(tt) do { if constexpr (Epi::RIDE) { \
        axf[0] = *(const PG8_LAS bf16x8*)(lds + XS_OFF + ((tt) & 3) * 2048 + lane * 16); axf[1] = *(const PG8_LAS bf16x8*)(lds + XS_OFF + ((tt) & 3) * 2048 + 1024 + lane * 16); } } while (0)
#define PG8_RIDE(tt) do { if constexpr (Epi::RIDE) { PG8_XMMA(B0); \
        const bool in_ = (tt) + 2 < nt; const unsigned xr_ = in_ ? xrow : (has_next ? (unsigned)(NP + 16 * nxt.pm) * (unsigned)K * 2u : xrow); const int ti_ = in_ ? (tt) + 2 : (tt) + 2 - nt; \
        PG8_XDMA(ti_, xr_); } } while (0)
    S.a_ready(cur);
    PG8_STAGE(PG8_SB(0, 0), cB, voffB); PG8_STAGE(PG8_SB(0, 1), cB + bhstep, voffB); PG8_STAGE(PG8_SA(0, 0), cA, voffA); PG8_STAGE(PG8_SA(0, 1), cA + hstep, voffA);
    if (wr == 1) PG8_BAR;
    PG8_WAIT_V(2); PG8_BAR;
    PG8_STAGE(PG8_SB(1, 0), cB + kstep, voffB); PG8_STAGE(PG8_SA(1, 0), cA + kstep, voffA); PG8_STAGE(PG8_SB(1, 1), cB + bhstep + kstep, voffB);
    PG8_WAIT_V(6); PG8_BAR;
    for (;;) {
        const bool has_next = S.next(ui + 1, nxt);
        const char* nA = has_next ? (const char*)g.A + (size_t)nxt.pm * tstep : cA; const char* nB = has_next ? (const char*)g.Bt + (size_t)nxt.pn * tstep : cB;
        for (int t = 0; t < nt; t += 2) {
            const bool last = (t == nt - 2);
            const char* a1 = cA + (size_t)(t + 1) * kstep;
            const char* a2 = last ? nA : cA + (size_t)(t + 2) * kstep; const char* b2 = last ? nB : cB + (size_t)(t + 2) * kstep;
            const char* a3 = a2 + kstep; const char* b3 = b2 + kstep;
            if (last && has_next) S.a_ready(nxt);
            if constexpr (Epi::PDMA) { if (last) E.pdma(lds + XP_OFF, cur, wid, lane); }
            PG8_LDB(B0, 0, 0); PG8_LDB(B1, 0, 1); PG8_SCHED; PG8_LDA(At, 0, 0); PG8_STAGE(PG8_SA(1, 1), a1 + hstep, voffA);
            PG8_WAIT_V(8); PG8_WAIT_L(0); PG8_BAR; PG8_MMA(0, 0, At, B0); PG8_MMA(0, 1, At, B1); PG8_BAR; PG8_SCHED;
            PG8_LDA(At, 0, 1); PG8_RIDE_LD(t); PG8_STAGE(PG8_SB(0, 0), b2, voffB); PG8_STAGE(PG8_SB(0, 1), b2 + bhstep, voffB); PG8_STAGE(PG8_SA(0, 0), a2, voffA);
            PG8_WAIT_V(8); PG8_WAIT_L(0); PG8_BAR; PG8_MMA(1, 0, At, B0); PG8_MMA(1, 1, At, B1); PG8_RIDE(t); PG8_BAR; PG8_SCHED;
            PG8_LDB(B0, 1, 0); PG8_LDB(B1, 1, 1); PG8_SCHED; PG8_LDA(At, 1, 0); PG8_STAGE(PG8_SA(0, 1), a2 + hstep, voffA);
            PG8_WAIT_V(8); PG8_WAIT_L(0); PG8_BAR; PG8_MMA(0, 0, At, B0); PG8_MMA(0, 1, At, B1); PG8_BAR; PG8_SCHED;
            PG8_LDA(At, 1, 1); PG8_RIDE_LD(t + 1); PG8_STAGE(PG8_SB(1, 0), b3, voffB); PG8_STAGE(PG8_SB(1, 1), b3 + bhstep, voffB); PG8_STAGE(PG8_SA(1, 0), a3, voffA);
            PG8_WAIT_V(8); PG8_WAIT_L(0); PG8_BAR; PG8_MMA(1, 0, At, B0); PG8_MMA(1, 1, At, B1); PG8_RIDE(t + 1); PG8_BAR; PG8_SCHED;
        }
        if constexpr (ALIGN_EPI) { if (wr == 0) PG8_BAR; }
        int fr_e = fr, fq_e = fq; asm volatile("" : "+v"(fr_e), "+v"(fq_e));
        if constexpr (Epi::RIDE) {
            if constexpr (Epi::FUSEX) E.fused(acc, accx, cur, wr, wc, fr_e, fq_e);
            else { E.extra(accx, cur, wr, wc, fr_e, fq_e); E(acc, cur, wr, wc, fr_e, fq_e); }
            accx[0] = (f32x4){0.f, 0.f, 0.f, 0.f}; accx[1] = accx[0]; if (has_next) xrow = (unsigned)(NP + 16 * nxt.pm) * (unsigned)K * 2u; }
        else E(acc, cur, wr, wc, fr_e, fq_e);
        S.done(cur);
        if (!has_next) break;
#pragma unroll
        for (int a = 0; a < 2; ++a)
#pragma unroll
            for (int b = 0; b < 2; ++b)
#pragma unroll
                for (int m = 0; m < 4; ++m)
#pragma unroll
                    for (int n = 0; n < 2; ++n) acc[a][b][m][n] = (f32x4){0.f, 0.f, 0.f, 0.f};
        cur = nxt; cA = nA; cB = nB; ++ui;
        if constexpr (ALIGN_EPI) { if (wr == 1) PG8_BAR; }
    }
    PG8_WAIT_V(0);
    if constexpr (!ALIGN_EPI) { if (wr == 0) PG8_BAR; }
    PG8_BAR;
#undef PG8_XMMA
#undef PG8_RIDE
#undef PG8_RIDE_LD
#undef PG8_XDMA
#undef PG8_SA
#undef PG8_SB
#undef PG8_STAGE
#undef PG8_LDA
#undef PG8_LDB
#undef PG8_MMA
#undef PG8_WAIT_V
#undef PG8_WAIT_L
#undef PG8_BAR
#undef PG8_SCHED
}
}

#define RLX_AGENT __ATOMIC_RELAXED, __HIP_MEMORY_SCOPE_AGENT
#define XB_TMO      128
#define XB_MISM     192
#define XB_XCNT(j)  (256  + 64 * (j))
#define XB_XSUB(j)  (1280 + 64 * (j))
#define XB_XGEN(j)  (2304 + 64 * (j))
#define XB_TOP      3328
#define XB_TOPGEN   3392
#define XCD_BAR_WORDS 3456
#define XB_SPIN_CAP (1u << 22)
__device__ __forceinline__ unsigned xb_ld(unsigned* p)              { return __hip_atomic_load(p, __ATOMIC_RELAXED, __HIP_MEMORY_SCOPE_AGENT); }
__device__ __forceinline__ unsigned xb_add(unsigned* p, unsigned v) { return __hip_atomic_fetch_add(p, v, __ATOMIC_RELAXED, __HIP_MEMORY_SCOPE_AGENT); }
__device__ __forceinline__ unsigned xb_xcc_id() { return (unsigned)__builtin_amdgcn_s_getreg((3 << 11) | 20) & 0xFu; }
#define XB_SPIN(cond, bar) do { unsigned _sp = 0; while (cond) { __builtin_amdgcn_s_sleep(1); \
    if ((++_sp & 255u) == 0u) { if (xb_ld(&(bar)[XB_TMO])) break; if (_sp > XB_SPIN_CAP) { atomicAdd(&(bar)[XB_TMO], 1u); break; } } } } while (0)
struct XcdBarrier { unsigned* bar; unsigned x; volatile LAS unsigned* st; };
__device__ __forceinline__ XcdBarrier xcd_barrier_post(unsigned* bar, volatile LAS unsigned* st) {
    XcdBarrier b; b.bar = bar; b.x = xb_xcc_id(); b.st = st;
    if (threadIdx.x == 0) { (void)xb_add(&bar[XB_XCNT(b.x)], 1u);
        if (b.x != (blockIdx.x & 7u) || gridDim.x != 256u) (void)xb_add(&bar[XB_MISM], 1u); }
    return b;
}
__device__ __forceinline__ void xcd_barrier_complete(unsigned* bar, unsigned x, unsigned& nloc, unsigned& nx) {
    const unsigned G = gridDim.x * gridDim.y * gridDim.z;
    unsigned sum, cnt, mine, sp = 0u;
    for (;;) {
        sum = 0u; cnt = 0u; mine = 0u;
#pragma unroll
        for (unsigned j = 0; j < 16; ++j) { const unsigned c = xb_ld(&bar[XB_XCNT(j)]); sum += c; cnt += (c > 0u) ? 1u : 0u; mine = (j == x) ? c : mine; }
        if (sum == G) break;
        __builtin_amdgcn_s_sleep(1);
        if ((++sp & 255u) == 0u) { if (xb_ld(&bar[XB_TMO])) break; if (sp > XB_SPIN_CAP) { atomicAdd(&bar[XB_TMO], 1u); break; } }
    }
    nloc = mine > 0u ? mine : 1u; nx = cnt > 0u ? cnt : 1u;
}
__device__ __forceinline__ void xcd_barrier(const XcdBarrier& b, bool local = false) {
    asm volatile("s_waitcnt vmcnt(0)" ::: "memory");
    __syncthreads();
    if (threadIdx.x == 0) {
        unsigned* bar = b.bar;
        __builtin_amdgcn_s_waitcnt(0);
        unsigned nloc = b.st[0], nx = b.st[1];
        if (nloc == 0u) { xcd_barrier_complete(bar, b.x, nloc, nx); b.st[0] = nloc; b.st[1] = nx; }
        const bool lt = local && b.st[2] != 0u;
        const unsigned old = xb_add(&bar[XB_XSUB(b.x)], 1u);
        const unsigned gen = old / nloc;
        if (old + 1u == (gen + 1u) * nloc) {
            if (!lt) {
                __builtin_amdgcn_fence(__ATOMIC_RELEASE, "agent");
                asm volatile("s_waitcnt vmcnt(0)" ::: "memory");
                const unsigned og = xb_add(&bar[XB_TOP], 1u);
                const unsigned tg = og / nx;
                asm volatile("buffer_inv sc1" ::: "memory");
                if (og + 1u == (tg + 1u) * nx) xb_add(&bar[XB_TOPGEN], 1u);
                else XB_SPIN(xb_ld(&bar[XB_TOPGEN]) == tg, bar);
                asm volatile("s_waitcnt vmcnt(0)" ::: "memory");
            } else asm volatile("buffer_inv sc0" ::: "memory");
            xb_add(&bar[XB_XGEN(b.x)], 1u);
            asm volatile("s_waitcnt vmcnt(0)" ::: "memory");
        } else {
            asm volatile("buffer_inv sc0" ::: "memory");
            XB_SPIN(xb_ld(&bar[XB_XGEN(b.x)]) == gen, bar);
            asm volatile("s_waitcnt vmcnt(0)" ::: "memory");
        }
    }
    __syncthreads();
}

struct Args { const float* in[22]; float* out; unsigned char* ws; };
typedef const __attribute__((address_space(4))) char* kptr_t;
__device__ __forceinline__ const void* karg(int byte_off) { kptr_t kp = (kptr_t)__builtin_amdgcn_kernarg_segment_ptr(); return *(const void* const volatile __attribute__((address_space(4)))*)(kp + byte_off); }
#define KIN(k) ((const float*)karg(8 * (k)))
#define KOUT ((float*)karg(176))
#define KWS ((unsigned char*)karg(184))
struct Frame {
    LAS unsigned char* lds; int tid, lane, wave, vcu, G;
};
__device__ __forceinline__ float wave_sum(float v) {
#pragma unroll
    for (int o = 1; o < 64; o <<= 1) v += __shfl_xor(v, o);
    return v;
}

__device__ __forceinline__ int up_row(int n) { const int f = n < DFF ? n : n - DFF; return (f >> 7) * 256 + (n < DFF ? 0 : 128) + (f & 127); }
__device__ __forceinline__ int qkv_row(int n0) { if (n0 >= 1280) return n0; const int h = n0 >> 6, half = (n0 >> 5) & 1; return (h >> 2) * 256 + half * 128 + (h & 3) * 32; }
struct TMat { const float* W; int K, N; bf16* WT; const float* gk; int rowmap; };
struct TItem { f32x4 v[8]; float gv[8]; };
__device__ __forceinline__ void titem_load(TItem& t, const TMat& m, int item, int lane) {
    const int nblk = m.N / 32, kb = item / nblk, nb = item % nblk, k0 = 64 * kb, n0 = 32 * nb;
    const int lk = lane >> 3, ln = 4 * (lane & 7);
#pragma unroll
    for (int i = 0; i < 8; ++i) t.v[i] = __builtin_nontemporal_load((const f32x4*)(m.W + (size_t)(k0 + 8 * i + lk) * m.N + n0 + ln));
    const float* gp = m.gk ? m.gk : m.W;
#pragma unroll
    for (int i = 0; i < 8; ++i) t.gv[i] = gp[k0 + 8 * i + lk];
}
__device__ __forceinline__ void titem_finish(const TItem& t, const TMat& m, LAS float* scr, int item, int lane) {
    const int nblk = m.N / 32, kb = item / nblk, nb = item % nblk, k0 = 64 * kb, n0 = 32 * nb;
    const int lk = lane >> 3, ln = 4 * (lane & 7);
#pragma unroll
    for (int i = 0; i < 8; ++i) { const int kk = 8 * i + lk; f32x4 x = t.v[i]; x = x * (m.gk ? t.gv[i] : 1.0f);
        LAS float* d = scr + kk * 33 + ln; d[0] = x[0]; d[1] = x[1]; d[2] = x[2]; d[3] = x[3]; }
    asm volatile("s_waitcnt lgkmcnt(0)" ::: "memory");
    const int c = lane & 7; const int r0 = m.rowmap == 1 ? up_row(n0) : (m.rowmap == 2 ? qkv_row(n0) : n0);
#pragma unroll
    for (int j = 0; j < 4; ++j) { const int n = (lane >> 3) + 8 * j; const LAS float* s = scr + (8 * c) * 33 + n;
        v4u o; o.x = pk2(s[0 * 33], s[1 * 33]); o.y = pk2(s[2 * 33], s[3 * 33]); o.z = pk2(s[4 * 33], s[5 * 33]); o.w = pk2(s[6 * 33], s[7 * 33]);
        *(GAS v4u*)(m.WT + (size_t)(r0 + n) * m.K + k0 + 8 * c) = o; }
    asm volatile("s_waitcnt lgkmcnt(0)" ::: "memory");
}
__device__ const double INVF[32] = {
    1.0, 0.7498942093324559, 0.5623413251903491, 0.4216965034285822, 0.31622776601683794, 0.23713737056616552, 0.1778279410038923, 0.1333521432163324,
    0.1, 0.07498942093324558, 0.05623413251903491, 0.042169650342858224, 0.03162277660168379, 0.023713737056616554, 0.01778279410038923, 0.01333521432163324,
    0.01, 0.007498942093324558, 0.005623413251903491, 0.004216965034285823, 0.0031622776601683794, 0.0023713737056616554, 0.0017782794100389228, 0.001333521432163324,
    0.001, 0.0007498942093324559, 0.0005623413251903491, 0.00042169650342858224, 0.00031622776601683794, 0.00023713737056616554, 0.00017782794100389227, 0.0001333521432163324};


__device__ __forceinline__ int cg_total(int group) {
    constexpr int I_IN = 16 * 128, I_OUT = 32 * 32, I_UP = 16 * 176, I_DN = 44 * 32, I_QKV = 16 * 48, I_O = 16 * 32;
    return group == 0 ? I_UP + I_IN + I_OUT : (group == 1 ? I_DN + I_QKV : I_UP + I_DN + I_O);
}
__device__ __forceinline__ int cg_mat(int group, int it, TMat& m) {
    unsigned char* ws = KWS;
    constexpr int I_IN = 16 * 128, I_UP = 16 * 176, I_DN = 44 * 32;
    int r = it;
    if (group == 0) {
        if (r < I_UP) { m = TMat{KIN(18), DM, UPW, (bf16*)(ws + WS_WUP0), KIN(17), 1}; return r; } r -= I_UP;
        if (r < I_IN) { m = TMat{KIN(6), DM, 4096, (bf16*)(ws + WS_WIN), KIN(5), 0}; return r; } r -= I_IN;
        m = TMat{KIN(11), SW, DM, (bf16*)(ws + WS_WOUT), nullptr, 0}; return r;
    } else if (group == 1) {
        if (r < I_DN) { m = TMat{KIN(21), DFF, DM, (bf16*)(ws + WS_WDN0), nullptr, 0}; return r; } r -= I_DN;
        m = TMat{KIN(12), DM, QKVW, (bf16*)(ws + WS_WQKV), KIN(5) + DM, 2}; return r;
    } else {
        if (r < I_UP) { m = TMat{KIN(18) + (size_t)DM * UPW, DM, UPW, (bf16*)(ws + WS_WUP1), KIN(17) + DM, 1}; return r; } r -= I_UP;
        if (r < I_DN) { m = TMat{KIN(21) + (size_t)DFF * DM, DFF, DM, (bf16*)(ws + WS_WDN1), nullptr, 0}; return r; } r -= I_DN;
        m = TMat{KIN(16), DM, DM, (bf16*)(ws + WS_WO), nullptr, 0}; return r;
    }
}
template <bool PAIR>
__device__ __forceinline__ void convert_group(int group, int w0, int nw, LAS unsigned char* lds, int wave, int lane) {
    LAS float* scr = (LAS float*)(lds + wave * 16384);
    const int total = cg_total(group);
    if (PAIR) {
        for (int it = w0; it < total; it += 2 * nw) {
            const bool hb = it + nw < total; const int itb = hb ? it + nw : it;
            TMat ma, mb; const int ra = cg_mat(group, it, ma), rb = cg_mat(group, itb, mb);
            TItem ta, tb; titem_load(ta, ma, ra, lane); titem_load(tb, mb, rb, lane);
            titem_finish(ta, ma, scr, ra, lane);
            if (hb) titem_finish(tb, mb, scr, rb, lane);
        }
    } else {
        for (int it = w0; it < total; it += nw) { TMat ma; const int ra = cg_mat(group, it, ma); TItem ta; titem_load(ta, ma, ra, lane); titem_finish(ta, ma, scr, ra, lane); }
    }
}


__device__ __forceinline__ void copy_old_cache(int i0, int i1, int t0, int nthr) {
    float* out = KOUT; const float* cache_k = KIN(2); const float* cache_v = KIN(3);
    for (int i = i0 + t0; i < i1; i += 4 * nthr) {
        f32x4 kk[4], vv[4]; size_t oo[4];
#pragma unroll
        for (int j = 0; j < 4; ++j) { int ii = i + j * nthr; if (ii >= i1) ii = i; const int c4 = ii & 63, r = ii >> 6, w = r % 120, b = r / 120; oo[j] = ((size_t)b * 128 + w) * 256 + c4 * 4;
            kk[j] = __builtin_nontemporal_load((const f32x4*)(cache_k + oo[j] + 8 * 256)); vv[j] = __builtin_nontemporal_load((const f32x4*)(cache_v + oo[j] + 8 * 256)); }
#pragma unroll
        for (int j = 0; j < 4; ++j) { *(f32x4*)(out + O_CKS + oo[j]) = kk[j]; *(f32x4*)(out + O_CVS + oo[j]) = vv[j]; } }
}
constexpr int COPY_ITEMS = NBS * 120 * 64, COPY_SPLIT = (COPY_ITEMS / 10) * 6;

__device__ __forceinline__ int crow(int r, int hi) { return (r & 3) + 8 * (r >> 2) + 4 * hi; }
__device__ __forceinline__ bf16x8 packp(const f32x16& p, int s) {
    v4u w; w.x = cvt_pk_bf16(p[8 * s + 0], p[8 * s + 1]); w.y = cvt_pk_bf16(p[8 * s + 2], p[8 * s + 3]); w.z = cvt_pk_bf16(p[8 * s + 4], p[8 * s + 5]); w.w = cvt_pk_bf16(p[8 * s + 6], p[8 * s + 7]);
    return __builtin_bit_cast(bf16x8, w);
}
__device__ __forceinline__ void softmax5(f32x16 (&p)[5], float sink_l2) {
    float m = sink_l2;
#pragma unroll
    for (int kt = 0; kt < 5; ++kt)
#pragma unroll
        for (int r = 0; r < 16; ++r) m = fmaxf(m, p[kt][r]);
    m = fmaxf(m, __shfl_xor(m, 32));
    float sum = 0.f;
#pragma unroll
    for (int kt = 0; kt < 5; ++kt)
#pragma unroll
        for (int r = 0; r < 16; ++r) { const float e = __builtin_amdgcn_exp2f(p[kt][r] - m); p[kt][r] = e; sum += e; }
    sum += __shfl_xor(sum, 32);
    const float rden = 1.0f / (sum + __builtin_amdgcn_exp2f(sink_l2 - m));
#pragma unroll
    for (int kt = 0; kt < 5; ++kt)
#pragma unroll
        for (int r = 0; r < 16; ++r) p[kt][r] *= rden;
}

constexpr int A_KST = 144, A_VST = 520, A_KOFF = 0, A_VOFF = 256 * A_KST, A_OOFF = A_VOFF + 64 * A_VST;
__device__ __forceinline__ void attn_unit_load(v4u (&kr)[4], v4u (&vr)[4], const bf16* Kn, const bf16* Vt, int b, int kvh, int qblk, int tid) {
#pragma unroll
    for (int i = 0; i < 4; ++i) { const int c = tid + 512 * i;
        { const int key = c >> 3, ch = c & 7; int pos = 128 * (qblk - 1) + key; if (pos < 0) pos = 0; kr[i] = *(const v4u*)(Kn + ((size_t)b * SEQ + pos) * 256 + kvh * HD + ch * 8); }
        { const int d = c >> 5, kc = c & 31; int pos = 128 * (qblk - 1) + 8 * kc; if (pos < 0) pos = 0; vr[i] = *(const v4u*)(Vt + ((size_t)(b * NKV + kvh) * HD + d) * SEQ + pos); } }
}
__device__ __forceinline__ void attn_unit_store(LAS unsigned char* lds, const v4u (&kr)[4], const v4u (&vr)[4], int tid) {
#pragma unroll
    for (int i = 0; i < 4; ++i) { const int c = tid + 512 * i;
        *(LAS v4u*)(lds + A_KOFF + (c >> 3) * A_KST + (c & 7) * 16) = kr[i];
        LAS v2u* vp = (LAS v2u*)(lds + A_VOFF + (c >> 5) * A_VST + (c & 31) * 16); vp[0] = (v2u){vr[i].x, vr[i].y}; vp[1] = (v2u){vr[i].z, vr[i].w}; }
}
__device__ __forceinline__ void attn_q_load(bf16x8 (&qf)[4], const bf16* Q, int b, int h, int qblk, int q0s, int lane) {
    const int r32 = lane & 31, hi = lane >> 5;
    const size_t qrow = (size_t)b * SEQ + 128 * qblk + q0s + r32;
#pragma unroll
    for (int d0 = 0; d0 < 4; ++d0) qf[d0] = *(const bf16x8*)(Q + qrow * DM + h * HD + 16 * d0 + 8 * hi);
}
__device__ __forceinline__ float softmax5e(f32x16 (&p)[5], float sink_l2) {
    float m = sink_l2;
#pragma unroll
    for (int kt = 0; kt < 5; ++kt)
#pragma unroll
        for (int r = 0; r < 16; ++r) m = fmaxf(m, p[kt][r]);
    m = fmaxf(m, __shfl_xor(m, 32));
    float sum = 0.f;
#pragma unroll
    for (int kt = 0; kt < 5; ++kt)
#pragma unroll
        for (int r = 0; r < 16; ++r) { const float e = __builtin_amdgcn_exp2f(p[kt][r] - m); p[kt][r] = e; sum += e; }
    sum += __shfl_xor(sum, 32);
    return 1.0f / (sum + __builtin_amdgcn_exp2f(sink_l2 - m));
}
__device__ __forceinline__ void attn_mask_bias(f32x16& mb0, f32x16& mb4, int lane) {
    const int r32 = lane & 31, hi = lane >> 5, a = r32 - 4 * hi;
#pragma unroll
    for (int r = 0; r < 16; ++r) { const int c0 = (r & 3) + 8 * (r >> 2); mb0[r] = (c0 > a) ? 0.f : -INFINITY; mb4[r] = (c0 <= a) ? 0.f : -INFINITY; }
}
constexpr int A_OST = 144, A_OSTG = 32 * A_OST;
__device__ __forceinline__ void attn_sub_lds(LAS unsigned char* lds, const bf16x8 (&qf)[4], const f32x16& mb0, const f32x16& mb4, bf16* O, float sink_l2, int b, int h, int qblk, int q0s, int wave, int lane) {
    const int r32 = lane & 31, hi = lane >> 5;
    f32x16 p[5];
#pragma unroll
    for (int kt = 0; kt < 5; ++kt) p[kt] = kt == 0 ? mb0 : (kt == 4 ? mb4 : (f32x16){0.f, 0.f, 0.f, 0.f, 0.f, 0.f, 0.f, 0.f, 0.f, 0.f, 0.f, 0.f, 0.f, 0.f, 0.f, 0.f});
#pragma unroll
    for (int d0 = 0; d0 < 4; ++d0)
#pragma unroll
        for (int kt = 0; kt < 5; ++kt) { const bf16x8 kf = *(const LAS bf16x8*)(lds + A_KOFF + (q0s + 32 * kt + r32) * A_KST + 16 * hi + 32 * d0);
            p[kt] = __builtin_amdgcn_mfma_f32_32x32x16_bf16(kf, qf[d0], p[kt], 0, 0, 0); }
    if (qblk == 0) {
#pragma unroll
        for (int kt = 0; kt < 4; ++kt) if (q0s + 32 * kt < 128) {
#pragma unroll
            for (int r = 0; r < 16; ++r) p[kt][r] = -INFINITY; } }
    const float rden = softmax5e(p, sink_l2);
    f32x16 o[2];
    o[0] = (f32x16){0.f, 0.f, 0.f, 0.f, 0.f, 0.f, 0.f, 0.f, 0.f, 0.f, 0.f, 0.f, 0.f, 0.f, 0.f, 0.f}; o[1] = o[0];
#pragma unroll
    for (int kt = 0; kt < 5; ++kt)
#pragma unroll
        for (int s = 0; s < 2; ++s) { const bf16x8 pf = packp(p[kt], s);
#pragma unroll
            for (int d0 = 0; d0 < 2; ++d0) { const LAS unsigned char* vp = lds + A_VOFF + (32 * d0 + r32) * A_VST + (q0s + 4 * hi) * 2;
                const v2u lo = *(const LAS v2u*)(vp + (32 * kt + 16 * s) * 2), hh = *(const LAS v2u*)(vp + (32 * kt + 16 * s + 8) * 2);
                v4u w; w.x = lo.x; w.y = lo.y; w.z = hh.x; w.w = hh.y;
                o[d0] = __builtin_amdgcn_mfma_f32_32x32x16_bf16(__builtin_bit_cast(bf16x8, w), pf, o[d0], 0, 0, 0); } }
    LAS unsigned char* stg = lds + A_OOFF + wave * A_OSTG;
#pragma unroll
    for (int d0 = 0; d0 < 2; ++d0)
#pragma unroll
        for (int g = 0; g < 4; ++g) { v2u w; w.x = cvt_pk_bf16(o[d0][4 * g] * rden, o[d0][4 * g + 1] * rden); w.y = cvt_pk_bf16(o[d0][4 * g + 2] * rden, o[d0][4 * g + 3] * rden);
            *(LAS v2u*)(stg + r32 * A_OST + (32 * d0 + 8 * g + 4 * hi) * 2) = w; }
    asm volatile("s_waitcnt lgkmcnt(0)" ::: "memory");
#pragma unroll
    for (int i = 0; i < 4; ++i) { const int row = 8 * i + (lane >> 3), ch = lane & 7; const v4u v = *(const LAS v4u*)(stg + row * A_OST + ch * 16);
        *(v4u*)(O + ((size_t)b * SEQ + 128 * qblk + q0s + row) * DM + h * HD + ch * 8) = v; }
    asm volatile("s_waitcnt lgkmcnt(0)" ::: "memory");
}

__device__ __forceinline__ void attn_sample_unit(const bf16* Qn, const bf16* Kn, const bf16* QKV, const float* ck, const float* cv, bf16* O, const float* sinks, int b, int kvh, int lane) {
    const int r32 = lane & 31, hi = lane >> 5, hh = r32 >> 3, qi = r32 & 7, h = 4 * kvh + hh;
    const size_t trow = (size_t)NP + 8 * b + qi;
    bf16x8 qf[4];
#pragma unroll
    for (int d0 = 0; d0 < 4; ++d0) qf[d0] = *(const bf16x8*)(Qn + trow * DM + h * HD + 16 * d0 + 8 * hi);
    f32x16 p[5];
#pragma unroll
    for (int kt = 0; kt < 4; ++kt) {
        const float* kr = ck + (((size_t)b * 128 + 32 * kt + r32) * NKV + kvh) * HD + 8 * hi;
        p[kt] = (f32x16){0.f, 0.f, 0.f, 0.f, 0.f, 0.f, 0.f, 0.f, 0.f, 0.f, 0.f, 0.f, 0.f, 0.f, 0.f, 0.f};
#pragma unroll
        for (int d0 = 0; d0 < 4; ++d0) { const f32x4 a = *(const f32x4*)(kr + 16 * d0), c = *(const f32x4*)(kr + 16 * d0 + 4);
            v4u w; w.x = pk2(a[0], a[1]); w.y = pk2(a[2], a[3]); w.z = pk2(c[0], c[1]); w.w = pk2(c[2], c[3]);
            p[kt] = __builtin_amdgcn_mfma_f32_32x32x16_bf16(__builtin_bit_cast(bf16x8, w), qf[d0], p[kt], 0, 0, 0); }
    }
    {
        const bf16* kr = Kn + ((size_t)NP + 8 * b + (r32 & 7)) * 256 + kvh * HD + 8 * hi;
        p[4] = (f32x16){0.f, 0.f, 0.f, 0.f, 0.f, 0.f, 0.f, 0.f, 0.f, 0.f, 0.f, 0.f, 0.f, 0.f, 0.f, 0.f};
#pragma unroll
        for (int d0 = 0; d0 < 4; ++d0) { v4u w = *(const v4u*)(kr + 16 * d0); if (r32 >= 8) w = (v4u){0u, 0u, 0u, 0u};
            p[4] = __builtin_amdgcn_mfma_f32_32x32x16_bf16(__builtin_bit_cast(bf16x8, w), qf[d0], p[4], 0, 0, 0); }
    }
    { const int a = qi - 4 * hi;
#pragma unroll
        for (int r = 0; r < 4; ++r) { if (!(r > a)) p[0][r] = -INFINITY; if (!(r <= a)) p[4][r] = -INFINITY; }
#pragma unroll
        for (int r = 4; r < 16; ++r) p[4][r] = -INFINITY; }
    softmax5(p, sinks[h] * LOG2E);
    f32x16 o[2];
#pragma unroll
    for (int d0 = 0; d0 < 2; ++d0) {
        o[d0] = (f32x16){0.f, 0.f, 0.f, 0.f, 0.f, 0.f, 0.f, 0.f, 0.f, 0.f, 0.f, 0.f, 0.f, 0.f, 0.f, 0.f};
#pragma unroll
        for (int kt = 0; kt < 4; ++kt)
#pragma unroll
            for (int s = 0; s < 2; ++s) {
                const float* vr = cv + (((size_t)b * 128 + 32 * kt + 16 * s + 4 * hi) * NKV + kvh) * HD + 32 * d0 + r32;
                float e[8];
#pragma unroll
                for (int j = 0; j < 8; ++j) e[j] = vr[(size_t)(8 * (j >> 2) + (j & 3)) * NKV * HD];
                v4u w; w.x = pk2(e[0], e[1]); w.y = pk2(e[2], e[3]); w.z = pk2(e[4], e[5]); w.w = pk2(e[6], e[7]);
                o[d0] = __builtin_amdgcn_mfma_f32_32x32x16_bf16(packp(p[kt], s), __builtin_bit_cast(bf16x8, w), o[d0], 0, 0, 0); }
        {
            const bf16* vr = QKV + ((size_t)8 * b + 4 * hi) * 256 + kvh * HD + 32 * d0 + r32;
            v4u w; w.x = (unsigned)vr[0] | ((unsigned)vr[256] << 16); w.y = (unsigned)vr[512] | ((unsigned)vr[768] << 16); w.z = 0u; w.w = 0u;
            o[d0] = __builtin_amdgcn_mfma_f32_32x32x16_bf16(packp(p[4], 0), __builtin_bit_cast(bf16x8, w), o[d0], 0, 0, 0); }
    }
#pragma unroll
    for (int d0 = 0; d0 < 2; ++d0)
#pragma unroll
        for (int r = 0; r < 16; ++r) { const int cr = crow(r, hi); O[((size_t)NP + 8 * b + (cr & 7)) * DM + (4 * kvh + (cr >> 3)) * HD + 32 * d0 + r32] = (bf16)f2bf(o[d0][r]); }
}


constexpr int AS_KST = 144, AS_VST = 328, AS_UNIT = 160 * AS_KST + 64 * AS_VST, AS_OOFF = 2 * AS_UNIT;
__device__ __forceinline__ void attn_sample_stage(LAS unsigned char* lds, const bf16* Kn, const bf16* Vs, const float* ck, const float* cv, int b, int kvh, int tid) {
#pragma unroll
    for (int i = 0; i < 4; ++i) { const int c = tid + 512 * i, key = c >> 4, d4 = c & 15;
        const f32x4 kx = *(const f32x4*)(ck + (((size_t)b * 128 + key) * NKV + kvh) * HD + 4 * d4), vx = *(const f32x4*)(cv + (((size_t)b * 128 + key) * NKV + kvh) * HD + 4 * d4);
        *(LAS v2u*)(lds + key * AS_KST + d4 * 8) = (v2u){pk2(kx[0], kx[1]), pk2(kx[2], kx[3])};
        LAS bf16* vp = (LAS bf16*)(lds + 160 * AS_KST + (4 * d4) * AS_VST) + key; const unsigned w0 = pk2(vx[0], vx[1]), w1 = pk2(vx[2], vx[3]);
        vp[0] = (bf16)(w0 & 0xffffu); vp[AS_VST / 2] = (bf16)(w0 >> 16); vp[2 * (AS_VST / 2)] = (bf16)(w1 & 0xffffu); vp[3 * (AS_VST / 2)] = (bf16)(w1 >> 16); }
    if (tid < 64) { const int j = tid >> 3, ch = tid & 7; *(LAS v4u*)(lds + (128 + j) * AS_KST + ch * 16) = *(const v4u*)(Kn + ((size_t)NP + 8 * b + j) * 256 + kvh * HD + ch * 8); }
    else if (tid < 64 + 216) { const int z = tid - 64; *(LAS v4u*)(lds + 136 * AS_KST + z * 16) = (v4u){0u, 0u, 0u, 0u}; }
    { const int j = tid >> 6, d = tid & 63; ((LAS bf16*)(lds + 160 * AS_KST + d * AS_VST))[128 + j] = Vs[((size_t)8 * b + j) * 256 + kvh * HD + d]; }
    if (tid < 384) { const int d = tid / 6, q = tid % 6; *(LAS v2u*)(lds + 160 * AS_KST + d * AS_VST + (136 + 4 * q) * 2) = (v2u){0u, 0u}; }
}
__device__ __forceinline__ void attn_sample_stage2(LAS unsigned char* lds, const bf16* Kn, const bf16* Vs, const float* ck, const float* cv, float* outp, int b, int kvh0, int tid) {
    f32x4 kx[2][4], vx[2][4]; v4u nk[2]; bf16 nv[2];
#pragma unroll
    for (int uu = 0; uu < 2; ++uu) { const int kvh = kvh0 + uu;
#pragma unroll
        for (int i = 0; i < 4; ++i) { const int c = tid + 512 * i, key = c >> 4, d4 = c & 15;
            kx[uu][i] = __builtin_nontemporal_load((const f32x4*)(ck + (((size_t)b * 128 + key) * NKV + kvh) * HD + 4 * d4)); vx[uu][i] = __builtin_nontemporal_load((const f32x4*)(cv + (((size_t)b * 128 + key) * NKV + kvh) * HD + 4 * d4)); }
        { const int t6 = tid & 63, j = t6 >> 3, ch = t6 & 7; nk[uu] = *(const v4u*)(Kn + ((size_t)NP + 8 * b + j) * 256 + kvh * HD + ch * 8); }
        { const int j = tid >> 6, d = tid & 63; nv[uu] = Vs[((size_t)8 * b + j) * 256 + kvh * HD + d]; } }
#pragma unroll
    for (int uu = 0; uu < 2; ++uu) { const int kvh = kvh0 + uu;
#pragma unroll
        for (int i = 0; i < 4; ++i) { const int c = tid + 512 * i, key = c >> 4, d4 = c & 15;
            if (key >= 8) { const size_t oo = (((size_t)b * 128 + key - 8) * NKV + kvh) * HD + 4 * d4; *(f32x4*)(outp + O_CKS + oo) = kx[uu][i]; *(f32x4*)(outp + O_CVS + oo) = vx[uu][i]; } } }
#pragma unroll
    for (int uu = 0; uu < 2; ++uu) { LAS unsigned char* L = lds + uu * AS_UNIT;
#pragma unroll
        for (int i = 0; i < 4; ++i) { const int c = tid + 512 * i, key = c >> 4, d4 = c & 15; const f32x4 k4 = kx[uu][i], v4 = vx[uu][i];
            *(LAS v2u*)(L + key * AS_KST + d4 * 8) = (v2u){pk2(k4[0], k4[1]), pk2(k4[2], k4[3])};
            LAS bf16* vp = (LAS bf16*)(L + 160 * AS_KST + (4 * d4) * AS_VST) + key; const unsigned w0 = pk2(v4[0], v4[1]), w1 = pk2(v4[2], v4[3]);
            vp[0] = (bf16)(w0 & 0xffffu); vp[AS_VST / 2] = (bf16)(w0 >> 16); vp[2 * (AS_VST / 2)] = (bf16)(w1 & 0xffffu); vp[3 * (AS_VST / 2)] = (bf16)(w1 >> 16); }
        if (tid < 64) { const int j = tid >> 3, ch = tid & 7; *(LAS v4u*)(L + (128 + j) * AS_KST + ch * 16) = nk[uu]; }
        else if (tid < 64 + 216) { const int z = tid - 64; *(LAS v4u*)(L + 136 * AS_KST + z * 16) = (v4u){0u, 0u, 0u, 0u}; }
        { const int j = tid >> 6, d = tid & 63; ((LAS bf16*)(L + 160 * AS_KST + d * AS_VST))[128 + j] = nv[uu]; }
        if (tid < 384) { const int d = tid / 6, q = tid % 6; *(LAS v2u*)(L + 160 * AS_KST + d * AS_VST + (136 + 4 * q) * 2) = (v2u){0u, 0u}; } }
}
__device__ __forceinline__ void attn_sample_q(bf16x8 (&qf)[4], float& sl2, const bf16* Q, const float* sinks, int b, int kvh, int lane) {
    const int r32 = lane & 31, hi = lane >> 5, hh = r32 >> 3, qi = r32 & 7, h = 4 * kvh + hh;
    const size_t trow = (size_t)NP + 8 * b + qi;
#pragma unroll
    for (int d0 = 0; d0 < 4; ++d0) qf[d0] = *(const bf16x8*)(Q + trow * DM + h * HD + 16 * d0 + 8 * hi);
    sl2 = sinks[h] * LOG2E;
}
__device__ __forceinline__ void attn_sample_lds(LAS unsigned char* lds, LAS unsigned char* ostage, const bf16x8 (&qf)[4], float sl2, bf16* O, int b, int kvh, int lane) {
    const int r32 = lane & 31, hi = lane >> 5, qi = r32 & 7;
    f32x16 p[5];
#pragma unroll
    for (int kt = 0; kt < 5; ++kt) p[kt] = (f32x16){0.f, 0.f, 0.f, 0.f, 0.f, 0.f, 0.f, 0.f, 0.f, 0.f, 0.f, 0.f, 0.f, 0.f, 0.f, 0.f};
#pragma unroll
    for (int d0 = 0; d0 < 4; ++d0)
#pragma unroll
        for (int kt = 0; kt < 5; ++kt) { const bf16x8 kf = *(const LAS bf16x8*)(lds + (32 * kt + r32) * AS_KST + 16 * hi + 32 * d0); p[kt] = __builtin_amdgcn_mfma_f32_32x32x16_bf16(kf, qf[d0], p[kt], 0, 0, 0); }
    { const int a = qi - 4 * hi;
#pragma unroll
        for (int r = 0; r < 4; ++r) { if (!(r > a)) p[0][r] = -INFINITY; if (!(r <= a)) p[4][r] = -INFINITY; }
#pragma unroll
        for (int r = 4; r < 16; ++r) p[4][r] = -INFINITY; }
    const float rden = softmax5e(p, sl2);
    f32x16 o[2];
    o[0] = (f32x16){0.f, 0.f, 0.f, 0.f, 0.f, 0.f, 0.f, 0.f, 0.f, 0.f, 0.f, 0.f, 0.f, 0.f, 0.f, 0.f}; o[1] = o[0];
#pragma unroll
    for (int kt = 0; kt < 5; ++kt)
#pragma unroll
        for (int s2 = 0; s2 < 2; ++s2) { const bf16x8 pf = packp(p[kt], s2);
#pragma unroll
            for (int d0 = 0; d0 < 2; ++d0) { const LAS unsigned char* vp = lds + 160 * AS_KST + (32 * d0 + r32) * AS_VST + (4 * hi) * 2;
                const v2u lo = *(const LAS v2u*)(vp + (32 * kt + 16 * s2) * 2), hv = *(const LAS v2u*)(vp + (32 * kt + 16 * s2 + 8) * 2);
                v4u w; w.x = lo.x; w.y = lo.y; w.z = hv.x; w.w = hv.y;
                o[d0] = __builtin_amdgcn_mfma_f32_32x32x16_bf16(__builtin_bit_cast(bf16x8, w), pf, o[d0], 0, 0, 0); } }
#pragma unroll
    for (int d0 = 0; d0 < 2; ++d0)
#pragma unroll
        for (int g = 0; g < 4; ++g) { v2u w; w.x = cvt_pk_bf16(o[d0][4 * g] * rden, o[d0][4 * g + 1] * rden); w.y = cvt_pk_bf16(o[d0][4 * g + 2] * rden, o[d0][4 * g + 3] * rden);
            *(LAS v2u*)(ostage + r32 * A_OST + (32 * d0 + 8 * g + 4 * hi) * 2) = w; }
    asm volatile("s_waitcnt lgkmcnt(0)" ::: "memory");
#pragma unroll
    for (int i = 0; i < 4; ++i) { const int row = 8 * i + (lane >> 3), ch = lane & 7; const v4u v = *(const LAS v4u*)(ostage + row * A_OST + ch * 16);
        *(v4u*)(O + ((size_t)NP + 8 * b + (row & 7)) * DM + (4 * kvh + (row >> 3)) * HD + ch * 8) = v; }
}

template <bool LAST>
__device__ __forceinline__ void mini_gemm_resid(const bf16* A, const bf16* Bt, int K, int job, const float* bb  , float* Y, bf16* XBo, float* rssq) {
    const int tid = tid_fresh(), lane = tid & 63, wave = __builtin_amdgcn_readfirstlane(tid >> 6), l15 = lane & 15, l4 = lane >> 4;
    const int rb = job >> 2, pn = job & 3, row = NP + 16 * rb + l15;
    const bf16* ap = A + (size_t)row * K + 8 * l4;
    const bf16* bp0 = Bt + (size_t)(256 * pn + 32 * wave + l15) * K + 8 * l4;
    const bf16* bp1 = bp0 + (size_t)16 * K;
    f32x4 acc0 = (f32x4){0.f, 0.f, 0.f, 0.f}, acc1 = acc0;
    bf16x8 a[4], b0[4], b1[4], an[4], b0n[4], b1n[4];
#pragma unroll
    for (int j = 0; j < 4; ++j) { a[j] = *(const bf16x8*)(ap + 32 * j); b0[j] = *(const bf16x8*)(bp0 + 32 * j); b1[j] = *(const bf16x8*)(bp1 + 32 * j); }
    for (int k0 = 128; k0 <= K; k0 += 128) {
        if (k0 < K) {
#pragma unroll
            for (int j = 0; j < 4; ++j) { an[j] = *(const bf16x8*)(ap + k0 + 32 * j); b0n[j] = *(const bf16x8*)(bp0 + k0 + 32 * j); b1n[j] = *(const bf16x8*)(bp1 + k0 + 32 * j); } }
#pragma unroll
        for (int j = 0; j < 4; ++j) { acc0 = __builtin_amdgcn_mfma_f32_16x16x32_bf16(b0[j], a[j], acc0, 0, 0, 0); acc1 = __builtin_amdgcn_mfma_f32_16x16x32_bf16(b1[j], a[j], acc1, 0, 0, 0); }
#pragma unroll
        for (int j = 0; j < 4; ++j) { a[j] = an[j]; b0[j] = b0n[j]; b1[j] = b1n[j]; }
    }
    float ss = 0.f;
#pragma unroll
    for (int nb = 0; nb < 2; ++nb) { const size_t off = (size_t)row * DM + 256 * pn + 32 * wave + 16 * nb + 4 * l4; const f32x4 o = *(const f32x4*)(bb + off) + (nb ? acc1 : acc0);
        *(f32x4*)(Y + off) = o;
        if (!LAST) { ss += o[0] * o[0] + o[1] * o[1] + o[2] * o[2] + o[3] * o[3]; v2u w; w.x = cvt_pk_bf16(o[0], o[1]); w.y = cvt_pk_bf16(o[2], o[3]); *(v2u*)(XBo + off) = w; } }
    if (!LAST) { ss += __shfl_xor(ss, 16); ss += __shfl_xor(ss, 32); if (l4 == 0) atomicAdd(rssq + row, ss); }
}

__global__ void __launch_bounds__(512, 2) fwd_mega(Args args) {
    extern __shared__ __attribute__((aligned(16))) unsigned char lds_raw[];
    LAS unsigned char* lds = (LAS unsigned char*)lds_raw;
    const int G = gridDim.x, bx = blockIdx.x;
#define PHASE_IDS const int tid = tid_fresh(), lane = tid & 63, wave = __builtin_amdgcn_readfirstlane(tid >> 6); const int gw = vcu * 8 + wave, NGW = G * 8, gt = bx * 512 + tid, NGT = G * 512; (void)lane; (void)wave; (void)gw; (void)NGW; (void)gt; (void)NGT;
    const int vcu = (G % 8 == 0) ? (bx % 8) * (G / 8) + bx / 8 : bx;
    gu32* ctl = (gu32*)(KWS + WS_CTL);
    volatile LAS unsigned* MISC = (volatile LAS unsigned*)(lds + MISC_OFF);
    { const int tid0 = tid_fresh(); for (int u = tid0; u < (LDS_BYTES - LDSCTL_OFF) / 4; u += 512) ((LAS unsigned*)(lds + LDSCTL_OFF))[u] = 0u; }
    __syncthreads();
    XcdBarrier bar = xcd_barrier_post((unsigned*)(ctl + CW_BAR), MISC + 8);
#define GRID_BAR() xcd_barrier(bar)
#define XCD_BAR()  xcd_barrier(bar, true)

    for (int rep = 0; rep < REP_P0; ++rep) {
        PHASE_IDS
        unsigned char* ws = KWS; const float* x_p = KIN(0); const float* x_s = KIN(1); const float* mix_g = KIN(5); const float* w_s = KIN(9);
        bf16* Wsb = (bf16*)(ws + WS_WSB); f32x2* rope = (f32x2*)(ws + WS_ROPE); bf16* XB = (bf16*)(ws + WS_XB);
        convert_group<true>(0, gw, NGW, lds, wave, lane);
        float* rss0 = (float*)(ws + CTL_RSS) + 3 * T;
        for (int m0 = 2 * gw; m0 < T; m0 += 2 * NGW) {
            f32x4 v[2][4]; float s[2];
#pragma unroll
            for (int r = 0; r < 2; ++r) { const int m = m0 + r; const float* xrow = (m < NP) ? x_p + (size_t)m * DM : x_s + (size_t)(m - NP) * DM; const GAS f32x4* xr = (const GAS f32x4*)xrow + lane;
#pragma unroll
                for (int j = 0; j < 4; ++j) v[r][j] = __builtin_nontemporal_load(xr + 64 * j); }
#pragma unroll
            for (int r = 0; r < 2; ++r) { s[r] = 0.f;
#pragma unroll
                for (int j = 0; j < 4; ++j) s[r] += (v[r][j].x * v[r][j].x + v[r][j].y * v[r][j].y) + (v[r][j].z * v[r][j].z + v[r][j].w * v[r][j].w); }
#pragma unroll
            for (int r = 0; r < 2; ++r) { const float ssq = wave_sum(s[r]); if (lane == 0) rss0[m0 + r] = ssq;
                GAS unsigned long long* o8 = (GAS unsigned long long*)(XB + (size_t)(m0 + r) * DM) + lane;
#pragma unroll
                for (int j = 0; j < 4; ++j) o8[64 * j] = (unsigned long long)pk2(v[r][j].x, v[r][j].y) | ((unsigned long long)pk2(v[r][j].z, v[r][j].w) << 32); }
        }
        for (int i = gt; i < 8 * 128 * 128; i += NGT) { const int s = i & 127, t = (i >> 7) & 127; Wsb[i] = (bf16)f2bf(s <= t ? w_s[i] : 0.f); }
        for (int i = gt; i < 2056 * 32; i += NGT) { const int pi = i >> 5, fi = i & 31; const double pos = (pi < SEQ) ? (double)pi : (double)(PAST + pi - SEQ);
            const double rev = pos * INVF[fi] * 0.15915494309189535; const float fr_ = (float)(rev - floor(rev));
            rope[i] = (f32x2){__builtin_amdgcn_cosf(fr_), __builtin_amdgcn_sinf(fr_)}; }
    }
    GRID_BAR();
    if (threadIdx.x == 0) MISC[10] = (xb_ld((unsigned*)(ctl + CW_BAR) + XB_MISM) == 0u && G == 256) ? 1u : 0u;

    for (int rep = 0; rep < REP_P1; ++rep) {
        unsigned char* ws = KWS;
        pg8::Gemm g{(bf16*)(ws + WS_XB), (bf16*)(ws + WS_WIN), NP, 4096, DM}; pg8::StaticOrder S; S.init(NP, 4096, G, bx);
        pg8::EpiGelu E{(bf16*)(ws + WS_U), (bf16*)(ws + WS_V), (float*)(ws + (rep < REP_P1 - 1 ? (size_t)768 * 1024 : CTL_LNS)), (const float*)(ws + CTL_RSS) + 3 * T, lds + XP_OFF};
        pg8::gemm_phase<pg8::EpiGelu, pg8::StaticOrder>(lds, g, S, E);
    }
    XCD_BAR();

    for (int rep = 0; rep < REP_P2; ++rep) {
        PHASE_IDS
        unsigned char* ws = KWS; float* out = KOUT; const float* ln_g = KIN(7); const float* ln_b = KIN(8); const float* w_s = KIN(9); const float* b_s = KIN(10);
        bf16* Ub = (bf16*)(ws + WS_U); bf16* Vb = (bf16*)(ws + WS_V); bf16* Wsb = (bf16*)(ws + WS_WSB); float* lnS = (float*)(ws + CTL_LNS);
        bf16* Uo = (rep < REP_P2 - 1) ? (bf16*)out : Ub;
        constexpr int RS = 80, WTILE = 128 * RS, WOFF = 8 * WTILE;
        const int l15 = lane & 15, l4 = lane >> 4, rl = lane >> 2, q4 = lane & 3;
        LAS unsigned char* wt = lds + wave * WTILE;
        v4u vraw[8]; f32x2 vst[8];
#define MIX_LOAD(unit_) do { const int c_ = (unit_) >> 3, g_ = (unit_) & 7; _Pragma("unroll") for (int i = 0; i < 8; ++i) { const size_t row_ = (size_t)c_ * 128 + rl + 16 * i; \
            vraw[i] = *(const v4u*)(Vb + row_ * SW + g_ * 256 + 32 * wave + q4 * 8); vst[i] = *(const f32x2*)(lnS + 2 * row_); } } while (0)
        const bool xmap = (G == 256); const int xq = bx & 7, li = bx >> 3;
#define MIX_UNIT(k_) (xmap ? ((((16 * xq + (li >> 3) + 4 * (k_)) << 3)) | (li & 7)) : bx + (k_) * G)
        int uk = 0; int unit = MIX_UNIT(0);
        if (unit < 1024) MIX_LOAD(unit);
        constexpr bool g_fixed = true;
        if (g_fixed) { const int gfix = xmap ? (li & 7) : (bx & 7);
            v4u wst[4];
#pragma unroll
            for (int q = 0; q < 4; ++q) { const int f = 8 * q + wave, mb = f >> 2, kk = f & 3; wst[q] = *(const v4u*)(Wsb + ((size_t)(gfix * 128 + 16 * mb + l15)) * 128 + 32 * kk + 8 * l4); }
#pragma unroll
            for (int q = 0; q < 4; ++q) *(LAS v4u*)(lds + WOFF + (8 * q + wave) * 1024 + lane * 16) = wst[q]; }
        f32x4 g0, g1, b0, b1; float bsv[8];
#define MIX_PARAMS(g_) do { const int cq_ = (g_) * 256 + 32 * wave + q4 * 8; g0 = *(const f32x4*)(ln_g + cq_); g1 = *(const f32x4*)(ln_g + cq_ + 4); b0 = *(const f32x4*)(ln_b + cq_); b1 = *(const f32x4*)(ln_b + cq_ + 4); \
            _Pragma("unroll") for (int mb = 0; mb < 8; ++mb) bsv[mb] = b_s[(g_) * 128 + 16 * mb + l15]; } while (0)
        if (g_fixed) MIX_PARAMS(xmap ? (li & 7) : (bx & 7));
        __syncthreads();
        for (; unit < 1024 && (!xmap || uk < 4); unit = MIX_UNIT(uk)) {
            ++uk; const int unext = (xmap && uk >= 4) ? 1024 : MIX_UNIT(uk);
            const int c = unit >> 3, g = unit & 7, R0 = c * 128, chw = g * 256 + 32 * wave;
            if (!g_fixed) MIX_PARAMS(g);
            {
#pragma unroll
                for (int i = 0; i < 8; ++i) { const float mu = vst[i].x * (1.f / SW), var = vst[i].y * (1.f / SW) - mu * mu, rstd = __builtin_amdgcn_rsqf(var + EPS); const v4u raw = vraw[i];
                    v4u w; w.x = pk2((bflo(raw.x) - mu) * rstd * g0[0] + b0[0], (bfhi(raw.x) - mu) * rstd * g0[1] + b0[1]); w.y = pk2((bflo(raw.y) - mu) * rstd * g0[2] + b0[2], (bfhi(raw.y) - mu) * rstd * g0[3] + b0[3]);
                    w.z = pk2((bflo(raw.z) - mu) * rstd * g1[0] + b1[0], (bfhi(raw.z) - mu) * rstd * g1[1] + b1[1]); w.w = pk2((bflo(raw.w) - mu) * rstd * g1[2] + b1[2], (bfhi(raw.w) - mu) * rstd * g1[3] + b1[3]);
                    *(LAS v4u*)(wt + (rl + 16 * i) * RS + q4 * 16) = w; }
            }
            v4u uraw[8];
#pragma unroll
            for (int i = 0; i < 8; ++i) uraw[i] = *(const v4u*)(Ub + (size_t)(R0 + rl + 16 * i) * SW + chw + q4 * 8);
            if (unext < 1024) MIX_LOAD(unext);
            f32x4 acc[8][2];
#pragma unroll
            for (int mb = 0; mb < 8; ++mb) { acc[mb][0] = (f32x4){0.f, 0.f, 0.f, 0.f}; acc[mb][1] = acc[mb][0]; }
#pragma unroll
            for (int kk = 0; kk < 4; ++kk) {
                bf16x8 vf[2];
#pragma unroll
                for (int nb = 0; nb < 2; ++nb) { const LAS bf16* p = (const LAS bf16*)(wt + (32 * kk + 8 * l4) * RS) + 16 * nb + l15;
                    v4u w; w.x = (unsigned)p[0] | ((unsigned)p[RS / 2] << 16); w.y = (unsigned)p[2 * (RS / 2)] | ((unsigned)p[3 * (RS / 2)] << 16); w.z = (unsigned)p[4 * (RS / 2)] | ((unsigned)p[5 * (RS / 2)] << 16); w.w = (unsigned)p[6 * (RS / 2)] | ((unsigned)p[7 * (RS / 2)] << 16);
                    vf[nb] = __builtin_bit_cast(bf16x8, w); }
#pragma unroll
                for (int mb = 0; mb < 8; ++mb) { if (32 * kk > 16 * mb + 15) continue;
                    const bf16x8 wf = g_fixed ? *(const LAS bf16x8*)(lds + WOFF + (mb * 4 + kk) * 1024 + lane * 16) : *(const bf16x8*)(Wsb + ((size_t)(g * 128 + 16 * mb + l15)) * 128 + 32 * kk + 8 * l4);
                    acc[mb][0] = __builtin_amdgcn_mfma_f32_16x16x32_bf16(vf[0], wf, acc[mb][0], 0, 0, 0); acc[mb][1] = __builtin_amdgcn_mfma_f32_16x16x32_bf16(vf[1], wf, acc[mb][1], 0, 0, 0); } }
#pragma unroll
            for (int mb = 0; mb < 8; ++mb) { const int t = 16 * mb + l15; const float bs = bsv[mb];
#pragma unroll
                for (int nb = 0; nb < 2; ++nb) { v2u w; w.x = pk2(acc[mb][nb][0] + bs, acc[mb][nb][1] + bs); w.y = pk2(acc[mb][nb][2] + bs, acc[mb][nb][3] + bs);
                    *(LAS v2u*)(wt + t * RS + (16 * nb + 4 * l4) * 2) = w; } }
#pragma unroll
            for (int i = 0; i < 8; ++i) { const v4u mx = *(const LAS v4u*)(wt + (rl + 16 * i) * RS + q4 * 16); const v4u u4 = uraw[i];
                v4u w; w.x = pk2(bflo(u4.x) * bflo(mx.x), bfhi(u4.x) * bfhi(mx.x)); w.y = pk2(bflo(u4.y) * bflo(mx.y), bfhi(u4.y) * bfhi(mx.y));
                w.z = pk2(bflo(u4.z) * bflo(mx.z), bfhi(u4.z) * bfhi(mx.z)); w.w = pk2(bflo(u4.w) * bflo(mx.w), bfhi(u4.w) * bfhi(mx.w));
                *(v4u*)(Uo + (size_t)(R0 + rl + 16 * i) * SW + chw + q4 * 8) = w; }
        }
#undef MIX_LOAD
#undef MIX_PARAMS
#undef MIX_UNIT
        if (wave < 2) {
            for (int item0 = (2 * bx + wave) * 64 + lane; item0 < 32768; item0 += 2 * G * 64) {
                const int item = xmap ? (((16 * xq) << 8) + li * 128 + wave * 64 + lane) : item0;
                const int b = item >> 8, cs = item & 255, g = cs >> 5, ch0 = cs * 8; const size_t r0 = (size_t)NP + 8 * b;
                v4u vr[8], ur[8]; f32x2 st8[8]; f32x4 wa[8], wb[4];
#pragma unroll
                for (int t = 0; t < 8; ++t) { st8[t] = *(const f32x2*)(lnS + 2 * (r0 + t)); vr[t] = *(const v4u*)(Vb + (r0 + t) * SW + ch0); }
                const f32x4 g0 = *(const f32x4*)(ln_g + ch0), g1 = *(const f32x4*)(ln_g + ch0 + 4), b0 = *(const f32x4*)(ln_b + ch0), b1 = *(const f32x4*)(ln_b + ch0 + 4);
                const f32x4 bsa = *(const f32x4*)(b_s + g * 128), bsb = *(const f32x4*)(b_s + g * 128 + 4);
#pragma unroll
                for (int t = 0; t < 8; ++t) { wa[t] = *(const f32x4*)(w_s + (size_t)(g * 128 + t) * 128); if (t >= 4) wb[t - 4] = *(const f32x4*)(w_s + (size_t)(g * 128 + t) * 128 + 4); }
#pragma unroll
                for (int t = 0; t < 8; ++t) ur[t] = *(const v4u*)(Ub + (r0 + t) * SW + ch0);
                float vn[8][8];
#pragma unroll
                for (int t = 0; t < 8; ++t) { const float mu = st8[t].x * (1.f / SW), var = st8[t].y * (1.f / SW) - mu * mu, rstd = __builtin_amdgcn_rsqf(var + EPS);
                    const v4u raw = vr[t];
                    float y[8]; y[0] = bflo(raw.x); y[1] = bfhi(raw.x); y[2] = bflo(raw.y); y[3] = bfhi(raw.y); y[4] = bflo(raw.z); y[5] = bfhi(raw.z); y[6] = bflo(raw.w); y[7] = bfhi(raw.w);
#pragma unroll
                    for (int j = 0; j < 8; ++j) vn[t][j] = (y[j] - mu) * rstd * (j < 4 ? g0[j & 3] : g1[j & 3]) + (j < 4 ? b0[j & 3] : b1[j & 3]);
                    float* so = out + O_SGUV + (r0 - NP + t) * SW + ch0;
                    *(f32x4*)so = (f32x4){vn[t][0], vn[t][1], vn[t][2], vn[t][3]}; *(f32x4*)(so + 4) = (f32x4){vn[t][4], vn[t][5], vn[t][6], vn[t][7]}; }
#pragma unroll
                for (int t = 0; t < 8; ++t) { float mx[8]; const float bs = t < 4 ? bsa[t & 3] : bsb[t & 3];
#pragma unroll
                    for (int j = 0; j < 8; ++j) mx[j] = bs;
#pragma unroll
                    for (int s2 = 0; s2 <= t; ++s2) { const float w = s2 < 4 ? wa[t][s2 & 3] : wb[(t - 4) & 3][s2 & 3];
#pragma unroll
                        for (int j = 0; j < 8; ++j) mx[j] += w * vn[s2][j]; }
                    const v4u uu2 = ur[t]; bf16* up = Uo + (r0 + t) * SW + ch0;
                    v4u w; w.x = pk2(bflo(uu2.x) * mx[0], bfhi(uu2.x) * mx[1]); w.y = pk2(bflo(uu2.y) * mx[2], bfhi(uu2.y) * mx[3]); w.z = pk2(bflo(uu2.z) * mx[4], bfhi(uu2.z) * mx[5]); w.w = pk2(bflo(uu2.w) * mx[6], bfhi(uu2.w) * mx[7]);
                    *(v4u*)up = w; }
            }
        }
    }
    XCD_BAR();

#if PROBE_P3NULL
    {
        unsigned char* ws = KWS;
        pg8::Gemm g{(bf16*)(ws + WS_U), (bf16*)(ws + WS_WOUT), NP, DM, SW}; pg8::StaticOrder S; S.init(NP, DM, G, bx);
        pg8::EpiNull2<(PROBE_P3NULL == 2)> E{(float*)(KOUT)};
        pg8::gemm_phase<pg8::EpiNull2<(PROBE_P3NULL == 2)>, pg8::StaticOrder>(lds, g, S, E);
    }
#endif
    for (int rep = 0; rep < REP_P3; ++rep) {
        unsigned char* ws = KWS; float* out = KOUT;
        pg8::Gemm g{(bf16*)(ws + WS_U), (bf16*)(ws + WS_WOUT), NP, DM, SW}; pg8::StaticOrder S; S.init(NP, DM, G, bx);
        pg8::EpiResid<1> E{nullptr, nullptr, out + O_Y, (bf16*)(ws + WS_XB), (float*)(ws + (rep < REP_P3 - 1 ? (size_t)768 * 1024 : CTL_RSS))};
        pg8::gemm_phase<pg8::EpiResid<1>, pg8::StaticOrder>(lds, g, S, E);
    }
    GRID_BAR();

#define FFN_LAYER(L, RSS_IN, RSS_OUT, LASTF) \
    for (int rep4 = 0; rep4 < ((L) == 0 ? REP_P4 : 1); ++rep4) { \
        unsigned char* ws = KWS; float* out = KOUT; float* rss = (float*)(ws + CTL_RSS); (void)rss; \
        pg8::Gemm g{(bf16*)(ws + WS_XB), (bf16*)(ws + ((L) ? WS_WUP1 : WS_WUP0)), T, UPW, DM}; pg8::BalOrder S; S.init(T, UPW, G, bx); \
        pg8::EpiUpConv E{(bf16*)(ws + WS_G), RSS_IN, KIN(19) + (size_t)(L) * 3 * UPW, KIN(20) + (size_t)(L) * UPW, KIN(4) + (size_t)(L) * NBS * 2 * UPW, (float*)(ws + WS_HB), out + O_STP + (size_t)(L) * NBP * 2 * UPW, out + O_STS + (size_t)(L) * NBS * 2 * UPW, (LAS float*)(lds + XS_OFF), lds + XP_OFF}; \
        pg8::gemm_phase<pg8::EpiUpConv, pg8::BalOrder>(lds, g, S, E); \
        int iidx, nidle; const bool idle = S.idle(bx, G, iidx, nidle); \
        if ((L) == 0) { if (idle) { PHASE_IDS convert_group<false>(1, iidx * 8 + wave, nidle * 8, lds, wave, lane); } __syncthreads(); } \
        (void)idle; \
    } \
    GRID_BAR(); \
    { \
        unsigned char* ws = KWS; float* out = KOUT; float* rss = (float*)(ws + CTL_RSS); (void)rss; \
        pg8::Gemm g{(bf16*)(ws + WS_G), (bf16*)(ws + ((L) ? WS_WDN1 : WS_WDN0)), NP, DM, DFF}; pg8::StaticOrder S; S.init(NP, DM, G, bx); \
        {   \
            PHASE_IDS \
            float* HB = (float*)(ws + WS_HB); bf16* Gb = (bf16*)(ws + WS_G); const float* cw = KIN(19) + (size_t)(L) * 3 * UPW; const float* cb = KIN(20) + (size_t)(L) * UPW; \
            pg8::Unit fu; \
            for (int ui = 0; S.next(ui, fu); ++ui) { const int pm = fu.pm; if ((pm & 7) == 0) continue; \
                  \
                f32x4 hb[2][2][4], wv[2][2][4]; \
                _Pragma("unroll") for (int it = 0; it < 2; ++it) { const int f = (tid + it * 512) * 4; if (it == 0 || tid < 192) { \
                    _Pragma("unroll") for (int bj = 0; bj < 2; ++bj) { const int c = bj * DFF + f; \
                        hb[it][bj][0] = *(const f32x4*)(HB + ((size_t)(pm - 1) * 4 + 2) * UPW + c); hb[it][bj][1] = *(const f32x4*)(HB + ((size_t)(pm - 1) * 4 + 3) * UPW + c); \
                        hb[it][bj][2] = *(const f32x4*)(HB + ((size_t)pm * 4 + 0) * UPW + c); hb[it][bj][3] = *(const f32x4*)(HB + ((size_t)pm * 4 + 1) * UPW + c); \
                        wv[it][bj][0] = *(const f32x4*)(cw + c); wv[it][bj][1] = *(const f32x4*)(cw + UPW + c); wv[it][bj][2] = *(const f32x4*)(cw + 2 * UPW + c); wv[it][bj][3] = *(const f32x4*)(cb + c); } } } \
                _Pragma("unroll") for (int it = 0; it < 2; ++it) { const int f = (tid + it * 512) * 4; if (it == 0 || tid < 192) { \
                    _Pragma("unroll") for (int t = 0; t < 2; ++t) { f32x4 cc[2]; \
                        _Pragma("unroll") for (int bj = 0; bj < 2; ++bj) cc[bj] = wv[it][bj][3] + wv[it][bj][2] * hb[it][bj][2 + t] + wv[it][bj][1] * hb[it][bj][1 + t] + wv[it][bj][0] * hb[it][bj][t]; \
                        f32x4 o; _Pragma("unroll") for (int x = 0; x < 4; ++x) o[x] = silu_f(cc[0][x]) * cc[1][x]; \
                        v2u w; w.x = pk2(o[0], o[1]); w.y = pk2(o[2], o[3]); *(v2u*)(Gb + (size_t)(pm * 256 + t) * DFF + f) = w; } } } } \
            asm volatile("s_waitcnt vmcnt(0)" ::: "memory"); __syncthreads(); \
        } \
        pg8::EpiResid<(LASTF) ? 2 : 1> E{nullptr, nullptr, out + O_Y, (bf16*)(ws + WS_XB), RSS_OUT}; \
        pg8::gemm_phase<pg8::EpiResid<(LASTF) ? 2 : 1>, pg8::StaticOrder>(lds, g, S, E); \
    }

#if REP_P4NULL
    {
        unsigned char* ws = KWS;
        pg8::Gemm g{(bf16*)(ws + WS_XB), (bf16*)(ws + WS_WUP0), T, UPW, DM}; pg8::StaticOrder S; S.init(T, UPW, G, bx);
        pg8::EpiNull E{(float*)(ws + WS_BIG + 100 * MiB)};
        pg8::gemm_phase<pg8::EpiNull, pg8::StaticOrder>(lds, g, S, E);
    }
#endif
    FFN_LAYER(0, rss, rss + T, false)
    GRID_BAR();

    for (int rep = 0; rep < REP_P7; ++rep) {
        unsigned char* ws = KWS;
        pg8::Gemm g{(bf16*)(ws + WS_XB), (bf16*)(ws + WS_WQKV), T, QKVW, DM}; pg8::BalOrder S; S.init(T, QKVW, G, bx);
        pg8::EpiQKV E{(bf16*)(ws + WS_QO), (bf16*)(ws + WS_KN), (bf16*)(ws + WS_VT), (bf16*)(ws + WS_QKV), (float*)(ws + CTL_RSS) + T, KIN(13), KIN(14), (const f32x2*)(ws + WS_ROPE), KOUT};
        pg8::gemm_phase<pg8::EpiQKV, pg8::BalOrder>(lds, g, S, E);
        { int iidx, nidle; if (S.idle(bx, G, iidx, nidle)) { PHASE_IDS convert_group<false>(2, iidx * 8 + wave, nidle * 8, lds, wave, lane); } if (REP_P7 > 1) __syncthreads(); }
    }
    GRID_BAR();

    for (int rep = 0; rep < REP_P9; ++rep) {
        PHASE_IDS
        unsigned char* ws = KWS; const float* cache_k = KIN(2); const float* cache_v = KIN(3); const float* sinks = KIN(15);
        bf16* QKV = (bf16*)(ws + WS_QKV); bf16* QO = (bf16*)(ws + WS_QO); bf16* Kn = (bf16*)(ws + WS_KN); bf16* Vt = (bf16*)(ws + WS_VT);
        bf16* Oo = (rep < REP_P9 - 1) ? (bf16*)(ws + WS_BIG + 102 * MiB) : QO;
        {
            const bool xmap = (G == 256); const int xq = bx & 7, li = bx >> 3;
#define ATT_UNIT(k_) (xmap ? ((xq << 6) | (li + 32 * (k_))) : bx + (k_) * G)
            f32x16 mb0, mb4; attn_mask_bias(mb0, mb4, lane);
            v4u kr[4], vr[4]; int uk = 0; int u = ATT_UNIT(0);
            if (u < 512) attn_unit_load(kr, vr, Kn, Vt, u >> 6, (u >> 4) & 3, u & 15, tid);
            for (; u < 512 && (!xmap || uk < 2); u = ATT_UNIT(uk)) {
                ++uk; const int unx = (xmap && uk >= 2) ? 512 : ATT_UNIT(uk);
                const int b = u >> 6, kvh = (u >> 4) & 3, qblk = u & 15;
                const int h = 4 * kvh + (wave >> 1); const float sl2 = sinks[h] * LOG2E;
                bf16x8 qa[4], qb[4];
                attn_q_load(qa, QO, b, h, qblk, 64 * (wave & 1), lane); attn_q_load(qb, QO, b, h, qblk, 64 * (wave & 1) + 32, lane);
                __syncthreads();
                attn_unit_store(lds, kr, vr, tid);
                __syncthreads();
                { const int un = (unx < 512) ? unx : u;
                  attn_unit_load(kr, vr, Kn, Vt, un >> 6, (un >> 4) & 3, un & 15, tid); }
                attn_sub_lds(lds, qa, mb0, mb4, Oo, sl2, b, h, qblk, 64 * (wave & 1), wave, lane);
                attn_sub_lds(lds, qb, mb0, mb4, Oo, sl2, b, h, qblk, 64 * (wave & 1) + 32, wave, lane);
            }
        }
        for (int sp0 = bx; sp0 < 256; sp0 += G) {
            const int sp = (G == 256) ? 32 * (bx & 7) + (bx >> 3) : sp0;
            const int b = sp >> 1, kvh0 = 2 * (sp & 1);
            bf16x8 qs[4]; float sl2s; attn_sample_q(qs, sl2s, QO, sinks, b, kvh0 + (wave & 1), lane);
            __syncthreads();
            attn_sample_stage2(lds, Kn, QKV, cache_k, cache_v, KOUT, b, kvh0, tid);
            __syncthreads();
            if (wave < 2) attn_sample_lds(lds + wave * AS_UNIT, lds + AS_OOFF + wave * A_OSTG, qs, sl2s, Oo, b, kvh0 + wave, lane);
        }
    }
    XCD_BAR();

    {
        unsigned char* ws = KWS; float* out = KOUT;
        pg8::Gemm g{(bf16*)(ws + WS_QO), (bf16*)(ws + WS_WO), NP, DM, DM}; pg8::StaticOrder S; S.init(NP, DM, G, bx);
        pg8::EpiResid<1> E{nullptr, nullptr, out + O_Y, (bf16*)(ws + WS_XB), (float*)(ws + CTL_RSS) + 2 * T};
        pg8::gemm_phase<pg8::EpiResid<1>, pg8::StaticOrder>(lds, g, S, E);
    }
    GRID_BAR();

    FFN_LAYER(1, rss + 2 * T, rss, true)
}

extern "C" void kernel_launch(void* const* d_in, const int* in_sizes, int n_in, void* d_out, int out_size, void* d_ws, size_t ws_size, hipStream_t stream) {
    static int grid = 0;
    if (grid == 0) {
        if (n_in != 22 || ws_size < WS_END) { fprintf(stderr, "kernel_launch: unexpected arguments (n_in %d, ws %zu)\n", n_in, ws_size); grid = -1; return; }
        int dev = 0, cus = 0;
        if (hipGetDevice(&dev) != hipSuccess || hipDeviceGetAttribute(&cus, hipDeviceAttributeMultiprocessorCount, dev) != hipSuccess) { grid = -1; return; }
        if (hipFuncSetAttribute((const void*)fwd_mega, hipFuncAttributeMaxDynamicSharedMemorySize, LDS_BYTES) != hipSuccess) { fprintf(stderr, "kernel_launch: hipFuncSetAttribute failed\n"); grid = -1; return; }
        int per_cu = 0;
        if (hipOccupancyMaxActiveBlocksPerMultiprocessor(&per_cu, (const void*)fwd_mega, 512, LDS_BYTES) != hipSuccess || per_cu < 1) fprintf(stderr, "kernel_launch: occupancy query reports %d blocks per CU\n", per_cu);
        (void)hipGetLastError();
        grid = cus & ~7;
        if (grid < 8) { grid = -1; return; }
    }
    if (grid < 0) return;
    (void)hipMemsetAsync((char*)d_ws + WS_CTL, 0, CTL_ZERO_BYTES, stream);
    Args a{};
    for (int i = 0; i < 22; ++i) a.in[i] = (const float*)d_in[i];
    a.out = (float*)d_out; a.ws = (unsigned char*)d_ws;
    hipLaunchKernelGGL(fwd_mega, dim3(grid), dim3(512), LDS_BYTES, stream, a);
}
```
